# Optimizing an MI355X kernel written in HIP

```python
import math
import jax, jax.numpy as jnp
from jax import lax
import numpy as np

D_MODEL = 1024
BATCH = 8
SEQ = 4096
DEPTH = 2

SSM_GROUP_CH = 16
SSM_GROUPS = D_MODEL // 32
SSM_WIDTH = SSM_GROUPS * SSM_GROUP_CH
SSM_STATE = 64
DT_MIN = 1e-3
DT_MAX = 1e-1
EIG_CLIP = 1e-4
HEAD_DIM = 64
ATTN_HEADS = D_MODEL // 128
ATTN_WIDTH = ATTN_HEADS * HEAD_DIM
Q_BLOCK = 128
N_IN = SSM_WIDTH + 3 * ATTN_WIDTH + ATTN_HEADS + 2 * D_MODEL
D_FF = ((8 * D_MODEL + 3 * 256 - 1) // (3 * 256)) * 256
N_MOD = 6
RMS_EPS = 1e-6

kernel_name = "hybrid_s5_fox_gated_block"


def rmsnorm(x, g):
    xf = x.astype(jnp.float32)
    r = lax.rsqrt(jnp.mean(xf * xf, axis=-1, keepdims=True) + RMS_EPS)
    return (xf * r * g.astype(jnp.float32)).astype(x.dtype)


def _linear_recurrence(e1, e2):
    a1, b1 = e1
    a2, b2 = e2
    return a1 * a2, a2 * b1 + b2


def s5_branch(u, lam_re, lam_im, log_dt, b_re, b_im, c_re, c_im, d_skip, w_glu, b_glu):
    dtype = u.dtype
    bsz, s, _ = u.shape
    f32 = jnp.float32
    uf = u.astype(f32).reshape(bsz, s, SSM_GROUPS, SSM_GROUP_CH)
    lam = lax.complex(jnp.minimum(lam_re.astype(f32), -EIG_CLIP), lam_im.astype(f32))
    dt = jnp.exp(log_dt.astype(f32))[:, None]
    lam_bar = jnp.exp(lam * dt)
    b = lax.complex(b_re.astype(f32), b_im.astype(f32))
    b_bar = ((lam_bar - 1.0) / lam)[..., None] * b
    bu = jnp.einsum('bsgh,gph->bsgp', uf, b_bar)
    a = jnp.broadcast_to(lam_bar, bu.shape)
    _, states = lax.associative_scan(_linear_recurrence, (a, bu), axis=1)
    cm = lax.complex(c_re.astype(f32), c_im.astype(f32))
    y = jnp.real(jnp.einsum('bsgp,ghp->bsgh', states, cm))
    y = y + d_skip.astype(f32).reshape(SSM_GROUPS, SSM_GROUP_CH) * uf
    y = y.reshape(bsz, s, SSM_WIDTH).astype(dtype)
    z = jax.nn.gelu(y)
    return z * jax.nn.sigmoid(z @ w_glu + b_glu)


def forgetting_attention(q, k, v, f_logit, b_f):
    bsz, s, _ = q.shape
    nb = s // Q_BLOCK
    f32 = jnp.float32
    q = q.reshape(bsz, s, ATTN_HEADS, HEAD_DIM).transpose(0, 2, 1, 3)
    k = k.reshape(bsz, s, ATTN_HEADS, HEAD_DIM).transpose(0, 2, 1, 3)
    v = v.reshape(bsz, s, ATTN_HEADS, HEAD_DIM).transpose(0, 2, 1, 3)
    log_f = jax.nn.log_sigmoid(f_logit.astype(f32) + b_f.astype(f32))
    cum = jnp.cumsum(log_f, axis=1).transpose(0, 2, 1)
    q_blocks = q.reshape(bsz, ATTN_HEADS, nb, Q_BLOCK, HEAD_DIM).transpose(2, 0, 1, 3, 4)
    cum_blocks = cum.reshape(bsz, ATTN_HEADS, nb, Q_BLOCK).transpose(2, 0, 1, 3)
    k_pos = jnp.arange(s)
    scale = HEAD_DIM ** -0.5

    def one_block(args):
        qb, cb, i = args
        logits = jnp.einsum('bhqd,bhkd->bhqk', qb, k).astype(f32) * scale
        logits = logits + cb[..., None] - cum[:, :, None, :]
        q_pos = i * Q_BLOCK + jnp.arange(Q_BLOCK)
        logits = jnp.where(k_pos[None, :] <= q_pos[:, None], logits, -jnp.inf)
        p = jax.nn.softmax(logits, axis=-1).astype(v.dtype)
        return jnp.einsum('bhqk,bhkd->bhqd', p, v)

    out = lax.map(one_block, (q_blocks, cum_blocks, jnp.arange(nb)))
    return out.transpose(1, 0, 3, 2, 4).reshape(bsz, s, ATTN_WIDTH)


def setup_inputs(seed: int = 0) -> dict:
    key = jax.random.key(seed)
    ks = jax.random.split(key, 32)
    f32 = jnp.float32
    nrm = lambda k, shape, s: jax.random.normal(k, shape, f32) * s
    L, D, G, P, H = DEPTH, D_MODEL, SSM_GROUPS, SSM_STATE, SSM_GROUP_CH
    lam_im0 = jnp.pi * jnp.arange(P, dtype=f32)
    return {
        "x": nrm(ks[0], (BATCH, SEQ, D), 1.0),
        "c": nrm(ks[1], (BATCH, D), 1.0),
        "w_ada": nrm(ks[2], (L, D, N_MOD * D), 0.5 * D ** -0.5),
        "b_ada": nrm(ks[3], (L, N_MOD * D), 0.02),
        "g_pre_mix": 1.0 + nrm(ks[4], (L, D), 0.02),
        "g_post_mix": 1.0 + nrm(ks[5], (L, D), 0.02),
        "g_pre_ffn": 1.0 + nrm(ks[6], (L, D), 0.02),
        "g_post_ffn": 1.0 + nrm(ks[7], (L, D), 0.02),
        "w_in": nrm(ks[8], (L, D, N_IN), D ** -0.5),
        "lam_re": -0.5 + nrm(ks[9], (L, G, P), 0.01),
        "lam_im": lam_im0 + nrm(ks[10], (L, G, P), 0.01),
        "log_dt": jax.random.uniform(ks[11], (L, G), f32, math.log(DT_MIN), math.log(DT_MAX)),
        "b_re": nrm(ks[12], (L, G, P, H), (2 * H) ** -0.5),
        "b_im": nrm(ks[13], (L, G, P, H), (2 * H) ** -0.5),
        "c_re": nrm(ks[14], (L, G, H, P), (2 * P) ** -0.5),
        "c_im": nrm(ks[15], (L, G, H, P), (2 * P) ** -0.5),
        "d_skip": nrm(ks[16], (L, SSM_WIDTH), 1.0),
        "w_glu": nrm(ks[17], (L, SSM_WIDTH, SSM_WIDTH), SSM_WIDTH ** -0.5),
        "b_glu": nrm(ks[18], (L, SSM_WIDTH), 0.02),
        "b_f": jax.random.uniform(ks[19], (L, ATTN_HEADS), f32, 1.0, 5.0),
        "w_pa": nrm(ks[20], (L, SSM_WIDTH, D), SSM_WIDTH ** -0.5),
        "w_pb": nrm(ks[21], (L, ATTN_WIDTH, D), ATTN_WIDTH ** -0.5),
        "w_o": nrm(ks[22], (L, D, D), D ** -0.5),
        "w_ffn_gate": nrm(ks[23], (L, D, D_FF), D ** -0.5),
        "w_ffn_up": nrm(ks[24], (L, D, D_FF), D ** -0.5),
        "w_ffn_down": nrm(ks[25], (L, D_FF, D), D_FF ** -0.5),
    }


def reference(x, c, w_ada, b_ada, g_pre_mix, g_post_mix, g_pre_ffn, g_post_ffn, w_in,
              lam_re, lam_im, log_dt, b_re, b_im, c_re, c_im, d_skip, w_glu, b_glu, b_f,
              w_pa, w_pb, w_o, w_ffn_gate, w_ffn_up, w_ffn_down):
    split_at = np.cumsum([SSM_WIDTH, ATTN_WIDTH, ATTN_WIDTH, ATTN_WIDTH, ATTN_HEADS, D_MODEL]).tolist()
    cond = jax.nn.silu(c)
    for l in range(DEPTH):
        mod = cond @ w_ada[l] + b_ada[l]
        shift_m, scale_m, gate_m, shift_f, scale_f, gate_f = jnp.split(mod[:, None, :], N_MOD, axis=-1)

        h = rmsnorm(x, g_pre_mix[l]) * (1.0 + scale_m) + shift_m
        proj = h @ w_in[l]
        u_ssm, q, k, v, f_logit, g_a, g_b = jnp.split(proj, split_at, axis=-1)
        y_ssm = s5_branch(u_ssm, lam_re[l], lam_im[l], log_dt[l], b_re[l], b_im[l],
                          c_re[l], c_im[l], d_skip[l], w_glu[l], b_glu[l])
        y_att = forgetting_attention(q, k, v, f_logit, b_f[l])
        merged = jax.nn.sigmoid(g_a) * (y_ssm @ w_pa[l]) + jax.nn.sigmoid(g_b) * (y_att @ w_pb[l])
        y = merged @ w_o[l]
        x = x + gate_m * rmsnorm(y, g_post_mix[l])

        h = rmsnorm(x, g_pre_ffn[l]) * (1.0 + scale_f) + shift_f
        y = (jax.nn.silu(h @ w_ffn_gate[l]) * (h @ w_ffn_up[l])) @ w_ffn_down[l]
        x = x + gate_f * rmsnorm(y, g_post_ffn[l])
    return x
```

```cpp
#include <hip/hip_runtime.h>
#include <hip/hip_cooperative_groups.h>
#include <cstdio>
#include <cstdint>
namespace cg = cooperative_groups;
__device__ __forceinline__ int tid_now() { int t = threadIdx.x; asm volatile("" : "+v"(t)); return t; }
namespace pg8 {
#define PG8_LAS __attribute__((address_space(3)))
typedef unsigned short bf16_t;
typedef short bf16x8 __attribute__((ext_vector_type(8)));
typedef float f32x4 __attribute__((ext_vector_type(4)));
typedef unsigned u32x4 __attribute__((ext_vector_type(4)));
constexpr int BM = 256, BK = 64, HALF = 128, HTB = HALF * BK * 2  , STAGE_BYTES = 8 * HTB, NXCD = 8, WGM = 8;

__host__ __device__ __forceinline__ int lds_byte(int r, int c) { const int st = (r >> 4) * 2 + (c >> 5), rr = r & 15, cc = c & 31, ob = rr * 64 + cc * 2; return st * 1024 + (ob ^ (((ob >> 9) & 1) << 5)); }
__host__ __device__ __forceinline__ void stage_rc(int b, int& R, int& C) { const int st = b / 1024, sb = b % 1024, swz = sb ^ (((sb >> 9) & 1) << 5); R = (st >> 1) * 16 + swz / 64; C = (st & 1) * 32 + (swz % 64) / 2; }
__host__ __device__ __forceinline__ int perm32(int rho) { const int n = rho >> 4, i = rho & 15; return 8 * (i >> 2) + 4 * n + (i & 3); }

struct Unit { int pm, pn; };
struct Gemm { const bf16_t* A; const bf16_t* Bt; int K, lda, ldb; };

struct StaticOrder {
    int nM, nN, nwg, G, c;
    __host__ __device__ void init(int M, int N, int G_, int c_) { nM = M / BM; nN = N / BM; nwg = nM * nN; G = G_; c = c_; }
    __host__ __device__ bool next(int i, Unit& u) const {
        const long L = (long)i * G + c; if (L >= nwg) return false;
        int wgid = (int)L; { const int q = nwg / NXCD, r = nwg % NXCD, xcd = wgid % NXCD, off = wgid / NXCD; wgid = (xcd < r ? xcd * (q + 1) : r * (q + 1) + (xcd - r) * q) + off; }
        const int nig = WGM * nN, gid = wgid / nig, fm = gid * WGM, gsz = (nM - fm) < WGM ? (nM - fm) : WGM;
        u.pm = fm + ((wgid % nig) % gsz); u.pn = (wgid % nig) / gsz; return true;
    }
    __device__ __forceinline__ void a_ready(const Unit&) const {}
    __device__ __forceinline__ void done(const Unit&) const {}
};

__device__ __forceinline__ unsigned cvt_pk_bf16(float lo, float hi) { unsigned r; asm volatile("v_cvt_pk_bf16_f32 %0, %1, %2" : "=v"(r) : "v"(lo), "v"(hi)); return r; }
typedef float f32x2 __attribute__((ext_vector_type(2)));
__device__ __forceinline__ f32x2 gelu_pk(f32x2 v) {
    const f32x2 av = __builtin_elementwise_abs(v), d = av * 0.2316418882f + 1.0f;
    f32x2 t; t.x = __builtin_amdgcn_rcpf(d.x); t.y = __builtin_amdgcn_rcpf(d.y);
    f32x2 q = t * 0.5307027145f + (-0.7265760135f); q = q * t + 0.7107068705f; q = q * t + (-0.142248368f); q = q * t + 0.127414796f; q = q * t;
    const f32x2 s = (v * v) * (-0.72134752044f);
    f32x2 e; e.x = __builtin_amdgcn_exp2f(s.x); e.y = __builtin_amdgcn_exp2f(s.y);
    const f32x2 m = v * (q * e), r = v - m;
    f32x2 o; o.x = v.x < 0.f ? m.x : r.x; o.y = v.y < 0.f ? m.y : r.y; return o;
}

template <int ACT  > struct EpiBf16 {
    static constexpr bool PERM = true, AFTER_DRAIN = false, HAS_MID = false; static_assert(ACT == 0 || ACT == 1, "EpiBf16: ACT is 0 (none) or 1 (gelu_pk)");
    bf16_t* O; int ldc; const float* bias; int split_cols; size_t split_stride; float scale0;
    __device__ __forceinline__ void operator()(const f32x4 (&acc)[2][2][4][2], const Unit& u, int wr, int wc, int fr, int fq) const {
        const int row0 = u.pm * BM + wr * 64 + fr; int colt = u.pn * BM; bf16_t* base = O;
        float sc = 1.f; if (split_cols) { const int t = colt / split_cols; base += (size_t)t * split_stride; colt -= t * split_cols; if (t == 0) sc = scale0; }
        const int col0 = colt + wc * 32 + 8 * fq, bcol0 = u.pn * BM + wc * 32 + 8 * fq;
        f32x4 bv[2][2];
#pragma unroll
        for (int bj = 0; bj < 2; ++bj)
#pragma unroll
            for (int n = 0; n < 2; ++n) bv[bj][n] = bias ? *(const f32x4*)(bias + bcol0 + bj * HALF + 4 * n) : (f32x4){0.f, 0.f, 0.f, 0.f};
#pragma unroll
        for (int ai = 0; ai < 2; ++ai)
#pragma unroll
            for (int m = 0; m < 4; ++m) { bf16_t* rowp = base + (size_t)(row0 + ai * HALF + m * 16) * ldc + col0;
#pragma unroll
                for (int bj = 0; bj < 2; ++bj) { f32x4 v0 = acc[ai][bj][m][0] + bv[bj][0], v1 = acc[ai][bj][m][1] + bv[bj][1];
                    if (ACT == 1) { f32x2 a = gelu_pk((f32x2){v0[0], v0[1]}), b = gelu_pk((f32x2){v0[2], v0[3]}), c = gelu_pk((f32x2){v1[0], v1[1]}), d = gelu_pk((f32x2){v1[2], v1[3]});
                        v0 = (f32x4){a.x, a.y, b.x, b.y}; v1 = (f32x4){c.x, c.y, d.x, d.y}; }
                    v0 = v0 * sc; v1 = v1 * sc; u32x4 w; w.x = cvt_pk_bf16(v0[0], v0[1]); w.y = cvt_pk_bf16(v0[2], v0[3]); w.z = cvt_pk_bf16(v1[0], v1[1]); w.w = cvt_pk_bf16(v1[2], v1[3]);
                    *(u32x4*)(rowp + bj * HALF) = w; } }
    }
};
typedef float f32x2e __attribute__((ext_vector_type(2)));
__device__ __forceinline__ float bf_lo(unsigned w) { return __uint_as_float(w << 16); }
__device__ __forceinline__ float bf_hi(unsigned w) { return __uint_as_float(w & 0xffff0000u); }
__device__ __forceinline__ void unpack8(const u32x4 w, float (&f)[8]) { f[0] = bf_lo(w.x); f[1] = bf_hi(w.x); f[2] = bf_lo(w.y); f[3] = bf_hi(w.y); f[4] = bf_lo(w.z); f[5] = bf_hi(w.z); f[6] = bf_lo(w.w); f[7] = bf_hi(w.w); }
__device__ __forceinline__ u32x4 pack8(const float (&f)[8]) { u32x4 w; w.x = cvt_pk_bf16(f[0], f[1]); w.y = cvt_pk_bf16(f[2], f[3]); w.z = cvt_pk_bf16(f[4], f[5]); w.w = cvt_pk_bf16(f[6], f[7]); return w; }
__device__ __forceinline__ float sigm(float a) { return __builtin_amdgcn_rcpf(1.0f + __builtin_amdgcn_exp2f(-1.4426950408889634f * a)); }
#define PG8_ACC8(f, ai, bj, m) do { const f32x4 _v0 = acc[ai][bj][m][0], _v1 = acc[ai][bj][m][1]; f[0] = _v0[0]; f[1] = _v0[1]; f[2] = _v0[2]; f[3] = _v0[3]; f[4] = _v1[0]; f[5] = _v1[1]; f[6] = _v1[2]; f[7] = _v1[3]; } while (0)

struct EpiWin {
    static constexpr bool PERM = true, AFTER_DRAIN = false, HAS_MID = false;
    bf16_t* proj; bf16_t* ing; float qscale;
    __device__ __forceinline__ void operator()(const f32x4 (&acc)[2][2][4][2], const Unit& u, int wr, int wc, int fr, int fq) const {
        const float sc = (u.pn == 2 || u.pn == 3) ? qscale : 1.0f;
#pragma unroll
        for (int ai = 0; ai < 2; ++ai)
#pragma unroll
            for (int m = 0; m < 4; ++m) { int row = u.pm * BM + ai * HALF + wr * 64 + m * 16 + fr; asm volatile("" : "+v"(row));
#pragma unroll
                for (int bj = 0; bj < 2; ++bj) { const int c0 = u.pn * BM + bj * HALF + wc * 32 + 8 * fq;
                    float f[8]; PG8_ACC8(f, ai, bj, m);
#pragma unroll
                    for (int j = 0; j < 8; ++j) f[j] *= sc;
                    bf16_t* dst;
                    if (u.pn < 2) { const int g = c0 >> 4, hi0 = c0 & 15, b = row >> 12, tok = row & 4095; dst = ing + ((size_t)(g * 2048 + b * 256 + (tok >> 4)) * 384 + (tok & 15) * 16 + hi0); }
                    else dst = proj + (size_t)row * 4096 + c0;
                    *(u32x4*)dst = pack8(f); asm volatile("" ::: "memory"); } }
    }
};
struct EpiS5E {
    static constexpr bool PERM = true, AFTER_DRAIN = true, HAS_MID = false;
    bf16_t* ing; const float* lamT;
    __device__ __forceinline__ void fused(f32x4 (&acc)[2][2][4][2], const Unit& u, int wr, int wc, int fr, int fq, PG8_LAS unsigned char* lds, int wid, int lane) const {
        PG8_LAS float* EL = (PG8_LAS float*)lds;
        PG8_LAS f32x2e* SEG = (PG8_LAS f32x2e*)(lds + 135168);
#pragma unroll
        for (int ai = 0; ai < 2; ++ai)
#pragma unroll
            for (int m = 0; m < 4; ++m) { PG8_LAS float* p = EL + (ai * HALF + wr * 64 + m * 16 + fr) * 132 + wc * 32 + 8 * fq;
                *(PG8_LAS f32x4*)p = acc[ai][0][m][0]; *(PG8_LAS f32x4*)(p + 4) = acc[ai][0][m][1]; }
        asm volatile("s_waitcnt lgkmcnt(0)" ::: "memory"); __builtin_amdgcn_s_barrier(); asm volatile("" ::: "memory");
        const float lr = lamT[2 * lane], li = lamT[2 * lane + 1];
        float xr = 0.f, xi = 0.f;
        for (int c = 32 * wid; c < 32 * wid + 32; ++c) { const f32x2e e = *(PG8_LAS f32x2e*)(EL + c * 132 + 2 * lane); const float nr = lr * xr - li * xi + e.x, ni = lr * xi + li * xr + e.y; xr = nr; xi = ni; }
        SEG[wid * 64 + lane] = (f32x2e){xr, xi};
        asm volatile("s_waitcnt lgkmcnt(0)" ::: "memory"); __builtin_amdgcn_s_barrier(); asm volatile("" ::: "memory");
        float pr = lr, pi = li;
#pragma unroll
        for (int s = 0; s < 5; ++s) { const float nr = pr * pr - pi * pi, ni = 2.f * pr * pi; pr = nr; pi = ni; }
        xr = 0.f; xi = 0.f;
        for (int j = 0; j < wid; ++j) { const f32x2e e = SEG[j * 64 + lane]; const float nr = pr * xr - pi * xi + e.x, ni = pr * xi + pi * xr + e.y; xr = nr; xi = ni; }
        for (int c = 32 * wid; c < 32 * wid + 32; ++c) {
            *(unsigned*)(ing + (size_t)(u.pm * BM + c) * 384 + 256 + 2 * lane) = cvt_pk_bf16(xr, xi);
            const f32x2e e = *(PG8_LAS f32x2e*)(EL + c * 132 + 2 * lane); const float nr = lr * xr - li * xi + e.x, ni = lr * xi + li * xr + e.y; xr = nr; xi = ni; }
        asm volatile("s_waitcnt vmcnt(0) lgkmcnt(0)" ::: "memory"); __threadfence(); __builtin_amdgcn_s_barrier(); asm volatile("" ::: "memory");
    }
};
struct EpiS5Main {
    static constexpr bool PERM = true, AFTER_DRAIN = false, HAS_MID = false;
    const bf16_t* ing; const float* dskip; bf16_t* z;
    __device__ __forceinline__ void operator()(const f32x4 (&acc)[2][2][4][2], const Unit& u, int wr, int wc, int fr, int fq) const {
        const int g = u.pn, b = u.pm & 7;
#pragma unroll
        for (int bj = 0; bj < 2; ++bj) { const int c0 = bj * HALF + wc * 32 + 8 * fq, t = c0 >> 4, ho0 = c0 & 15;
            const f32x4 d0 = *(const f32x4*)(dskip + g * 16 + ho0), d1 = *(const f32x4*)(dskip + g * 16 + ho0 + 4);
            const float dk[8] = {d0[0], d0[1], d0[2], d0[3], d1[0], d1[1], d1[2], d1[3]};
#pragma unroll
            for (int ai = 0; ai < 2; ++ai)
#pragma unroll
                for (int m = 0; m < 4; ++m) { int c = ai * HALF + wr * 64 + m * 16 + fr; asm volatile("" : "+v"(c));
                    float f[8], uu[8]; PG8_ACC8(f, ai, bj, m); unpack8(*(const u32x4*)(ing + (size_t)(u.pm * BM + c) * 384 + c0), uu);
#pragma unroll
                    for (int j = 0; j < 8; ++j) { const float y = f[j] + dk[j] * uu[j]; f[j] = y * sigm(1.5957691216057308f * (y + 0.044715f * y * y * y)); }
                    *(u32x4*)(z + (size_t)(b * 4096 + c * 16 + t) * 512 + g * 16 + ho0) = pack8(f); asm volatile("" ::: "memory"); } }
    }
};
struct EpiGlu {
    static constexpr bool PERM = true, AFTER_DRAIN = false, HAS_MID = false;
    const bf16_t* z; const float* bglu; bf16_t* proj;
    __device__ __forceinline__ void operator()(const f32x4 (&acc)[2][2][4][2], const Unit& u, int wr, int wc, int fr, int fq) const {
#pragma unroll
        for (int bj = 0; bj < 2; ++bj) { const int c0 = u.pn * BM + bj * HALF + wc * 32 + 8 * fq;
            const f32x4 b0 = *(const f32x4*)(bglu + c0), b1 = *(const f32x4*)(bglu + c0 + 4);
            const float bb[8] = {b0[0], b0[1], b0[2], b0[3], b1[0], b1[1], b1[2], b1[3]};
#pragma unroll
            for (int ai = 0; ai < 2; ++ai)
#pragma unroll
                for (int m = 0; m < 4; ++m) { int row = u.pm * BM + ai * HALF + wr * 64 + m * 16 + fr; asm volatile("" : "+v"(row));
                    float f[8], zz[8]; PG8_ACC8(f, ai, bj, m); unpack8(*(const u32x4*)(z + (size_t)row * 512 + c0), zz);
#pragma unroll
                    for (int j = 0; j < 8; ++j) f[j] = zz[j] * sigm(f[j] + bb[j]);
                    *(u32x4*)(proj + (size_t)row * 4096 + c0) = pack8(f); asm volatile("" ::: "memory"); } }
    }
};
struct EpiMerge {
    static constexpr bool PERM = true, AFTER_DRAIN = false, HAS_MID = true;
    const bf16_t* proj; bf16_t* mg; int mid_t;
    __device__ __forceinline__ void mid(f32x4 (&acc)[2][2][4][2], const Unit& u, int wr, int wc, int fr, int fq) const {
#pragma unroll
        for (int ai = 0; ai < 2; ++ai)
#pragma unroll
            for (int m = 0; m < 4; ++m) { int row = u.pm * BM + ai * HALF + wr * 64 + m * 16 + fr; asm volatile("" : "+v"(row));
#pragma unroll
                for (int bj = 0; bj < 2; ++bj) { const int c0 = u.pn * BM + bj * HALF + wc * 32 + 8 * fq;
                    float ga[8], gb[8]; unpack8(*(const u32x4*)(proj + (size_t)row * 4096 + 2048 + c0), ga); unpack8(*(const u32x4*)(proj + (size_t)row * 4096 + 3072 + c0), gb);
                    float r[8];
#pragma unroll
                    for (int j = 0; j < 8; ++j) r[j] = (1.0f + __builtin_amdgcn_exp2f(-1.4426950408889634f * gb[j])) * __builtin_amdgcn_rcpf(1.0f + __builtin_amdgcn_exp2f(-1.4426950408889634f * ga[j]));
                    acc[ai][bj][m][0] *= (f32x4){r[0], r[1], r[2], r[3]}; acc[ai][bj][m][1] *= (f32x4){r[4], r[5], r[6], r[7]};
                    asm volatile("" : "+v"(acc[ai][bj][m][0]), "+v"(acc[ai][bj][m][1]) :: "memory"); } }
    }
    __device__ __forceinline__ void operator()(const f32x4 (&acc)[2][2][4][2], const Unit& u, int wr, int wc, int fr, int fq) const {
#pragma unroll
        for (int ai = 0; ai < 2; ++ai)
#pragma unroll
            for (int m = 0; m < 4; ++m) { int row = u.pm * BM + ai * HALF + wr * 64 + m * 16 + fr; asm volatile("" : "+v"(row));
#pragma unroll
                for (int bj = 0; bj < 2; ++bj) { const int c0 = u.pn * BM + bj * HALF + wc * 32 + 8 * fq;
                    float f[8], gb[8]; PG8_ACC8(f, ai, bj, m); unpack8(*(const u32x4*)(proj + (size_t)row * 4096 + 3072 + c0), gb);
#pragma unroll
                    for (int j = 0; j < 8; ++j) f[j] *= sigm(gb[j]);
                    *(u32x4*)(mg + (size_t)row * 1024 + c0) = pack8(f); asm volatile("" ::: "memory"); } }
    }
};
struct EpiSwiglu {
    static constexpr bool PERM = true, AFTER_DRAIN = false, HAS_MID = false;
    bf16_t* hh;
    __device__ __forceinline__ void operator()(const f32x4 (&acc)[2][2][4][2], const Unit& u, int wr, int wc, int fr, int fq) const {
#pragma unroll
        for (int ai = 0; ai < 2; ++ai)
#pragma unroll
            for (int m = 0; m < 4; ++m) { int row = u.pm * BM + ai * HALF + wr * 64 + m * 16 + fr; asm volatile("" : "+v"(row));
                float gt[8], up[8]; PG8_ACC8(gt, ai, 0, m); PG8_ACC8(up, ai, 1, m);
#pragma unroll
                for (int j = 0; j < 8; ++j) gt[j] = gt[j] * sigm(gt[j]) * up[j];
                *(u32x4*)(hh + (size_t)row * 2816 + u.pn * HALF + wc * 32 + 8 * fq) = pack8(gt); }
    }
};
struct OneUnit { int pm, pn;
    __device__ __forceinline__ bool next(int i, Unit& u) const { if (i) return false; u.pm = pm; u.pn = pn; return true; }
    __device__ __forceinline__ void a_ready(const Unit&) const {}
    __device__ __forceinline__ void done(const Unit&) const {} };
template <class Epi, class Sched, bool ALIGN_EPI = false, bool SP2 = false>
__device__ __forceinline__ void gemm_phase(PG8_LAS unsigned char* lds, const Gemm g, const Sched& S, const Epi& E) {
    const int tid = tid_now(), wid = __builtin_amdgcn_readfirstlane(tid >> 6), lane = tid & 63, wr = wid >> 2, wc = wid & 3, fr = lane & 15, fq = lane >> 4;
    int K = g.K; asm volatile("" : "+s"(K)); const int nt = K / BK;
    unsigned voffA[2], voffB[2];
#pragma unroll
    for (int i = 0; i < 2; ++i) { int R, C; stage_rc(tid * 16 + i * 8192, R, C); const int Rb = Epi::PERM ? ((R & ~31) + perm32(R & 31)) : R;
        voffA[i] = (unsigned)(R * g.lda + C) * 2u; voffB[i] = (unsigned)(Rb * g.ldb + C) * 2u; }
    const size_t kstep = (size_t)(BK * 2);
    const unsigned hsA = (unsigned)HALF * g.lda * 2u, hsB = (unsigned)HALF * g.ldb * 2u;
    const unsigned tsA = 2u * hsA, tsB = 2u * hsB;
    const unsigned ldsw = (unsigned)wid * 1024u;
    const int aoff = lds_byte(wr * 64 + fr, fq * 8), boff = lds_byte(wc * 32 + fr, fq * 8);
#define PG8_SA(b, h) (((b) * 2 + (h)) * HTB)
#define PG8_SB(b, h) ((4 + (b) * 2 + (h)) * HTB)
#define PG8_STAGE(bufoff, gbase, voff) do { _Pragma("unroll") for (int _i = 0; _i < 2; ++_i) \
        __builtin_amdgcn_global_load_lds((const unsigned*)((const char*)(gbase) + (voff)[_i]), (PG8_LAS unsigned*)(lds + (bufoff) + ldsw + _i * 8192), 16, 0, 0); } while (0)
#define PG8_LDA(dst, b, h) do { _Pragma("unroll") for (int m = 0; m < 4; ++m) _Pragma("unroll") for (int k = 0; k < 2; ++k) dst[m][k] = *(const PG8_LAS bf16x8*)(lds + PG8_SA(b, h) + aoff + m * 2048 + k * 1024); } while (0)
#define PG8_LDB(dst, b, h) do { _Pragma("unroll") for (int n = 0; n < 2; ++n) _Pragma("unroll") for (int k = 0; k < 2; ++k) dst[n][k] = *(const PG8_LAS bf16x8*)(lds + PG8_SB(b, h) + boff + n * 2048 + k * 1024); } while (0)
#define PG8_MMA(ai, bj, At, Bt) do { __builtin_amdgcn_s_setprio(1); _Pragma("unroll") for (int m = 0; m < 4; ++m) _Pragma("unroll") for (int n = 0; n < 2; ++n) _Pragma("unroll") for (int k = 0; k < 2; ++k) \
        acc[ai][bj][m][n] = __builtin_amdgcn_mfma_f32_16x16x32_bf16(Bt[n][k], At[m][k], acc[ai][bj][m][n], 0, 0, 0); __builtin_amdgcn_s_setprio(0); } while (0)
#define PG8_WAIT_V(n) asm volatile("s_waitcnt vmcnt(" #n ")" ::: "memory")
#define PG8_WAIT_L(n) asm volatile("s_waitcnt lgkmcnt(" #n ")" ::: "memory")
#define PG8_BAR __builtin_amdgcn_s_barrier()
#define PG8_SCHED __builtin_amdgcn_sched_barrier(0)
    Unit cur, nxt; int ui = 0;
    if (!S.next(0, cur)) return;
    f32x4 acc[2][2][4][2];
#pragma unroll
    for (int a = 0; a < 2; ++a)
#pragma unroll
        for (int b = 0; b < 2; ++b)
#pragma unroll
            for (int m = 0; m < 4; ++m)
#pragma unroll
                for (int n = 0; n < 2; ++n) acc[a][b][m][n] = (f32x4){0.f, 0.f, 0.f, 0.f};
    bf16x8 At[4][2], B0[2][2], B1[2][2];
    const char* cA = (const char*)g.A + (size_t)cur.pm * tsA; const char* cB = (const char*)g.Bt + (size_t)cur.pn * tsB;
    S.a_ready(cur);
    if constexpr (SP2) {
        PG8_STAGE(PG8_SB(0, 0), cB, voffB); PG8_STAGE(PG8_SB(0, 1), cB + hsB, voffB); PG8_STAGE(PG8_SA(0, 0), cA, voffA); PG8_STAGE(PG8_SA(0, 1), cA + hsA, voffA);
        if (wr == 1) PG8_BAR;
        PG8_WAIT_V(2); PG8_BAR;
        PG8_STAGE(PG8_SB(1, 0), cB + kstep, voffB); PG8_STAGE(PG8_SA(1, 0), cA + kstep, voffA); PG8_STAGE(PG8_SB(1, 1), cB + hsB + kstep, voffB);
        PG8_WAIT_V(6); PG8_BAR;
    } else {
        PG8_STAGE(PG8_SB(0, 0), cB, voffB); PG8_STAGE(PG8_SA(0, 0), cA, voffA); PG8_STAGE(PG8_SB(0, 1), cB + hsB, voffB); PG8_STAGE(PG8_SA(0, 1), cA + hsA, voffA);
        if (wr == 1) PG8_BAR;
        PG8_WAIT_V(4); PG8_BAR;
        PG8_STAGE(PG8_SB(1, 0), cB + kstep, voffB); PG8_STAGE(PG8_SA(1, 0), cA + kstep, voffA); PG8_STAGE(PG8_SB(1, 1), cB + hsB + kstep, voffB);
        PG8_WAIT_V(6); PG8_BAR;
    }
    for (;;) {
        const bool has_next = S.next(ui + 1, nxt);
        const char* nA = has_next ? (const char*)g.A + (size_t)nxt.pm * tsA : cA; const char* nB = has_next ? (const char*)g.Bt + (size_t)nxt.pn * tsB : cB;
        for (int t = 0; t < nt; t += 2) {
            if constexpr (Epi::HAS_MID) { if (t == E.mid_t) { const int l2 = tid_now() & 63; E.mid(acc, cur, wr, wc, l2 & 15, l2 >> 4); } }
            const bool last = (t == nt - 2);
            const char* a1 = cA + (size_t)(t + 1) * kstep;
            const char* a2 = last ? nA : cA + (size_t)(t + 2) * kstep; const char* b2 = last ? nB : cB + (size_t)(t + 2) * kstep;
            const char* a3 = a2 + kstep; const char* b3 = b2 + kstep;
            if (last && has_next) S.a_ready(nxt);
            if constexpr (SP2) {
            PG8_LDB(B0, 0, 0); PG8_LDB(B1, 0, 1); PG8_SCHED; PG8_LDA(At, 0, 0); PG8_STAGE(PG8_SA(1, 1), a1 + hsA, voffA);
            PG8_WAIT_V(8); PG8_WAIT_L(0); PG8_BAR; PG8_MMA(0, 0, At, B0); PG8_MMA(0, 1, At, B1); PG8_BAR; PG8_SCHED;
            PG8_LDA(At, 0, 1); PG8_STAGE(PG8_SB(0, 0), b2, voffB); PG8_STAGE(PG8_SB(0, 1), b2 + hsB, voffB); PG8_STAGE(PG8_SA(0, 0), a2, voffA);
            PG8_WAIT_V(8); PG8_WAIT_L(0); PG8_BAR; PG8_MMA(1, 0, At, B0); PG8_MMA(1, 1, At, B1); PG8_BAR; PG8_SCHED;
            PG8_LDB(B0, 1, 0); PG8_LDB(B1, 1, 1); PG8_SCHED; PG8_LDA(At, 1, 0); PG8_STAGE(PG8_SA(0, 1), a2 + hsA, voffA);
            PG8_WAIT_V(8); PG8_WAIT_L(0); PG8_BAR; PG8_MMA(0, 0, At, B0); PG8_MMA(0, 1, At, B1); PG8_BAR; PG8_SCHED;
            PG8_LDA(At, 1, 1); PG8_STAGE(PG8_SB(1, 0), b3, voffB); PG8_STAGE(PG8_SB(1, 1), b3 + hsB, voffB); PG8_STAGE(PG8_SA(1, 0), a3, voffA);
            PG8_WAIT_V(8); PG8_WAIT_L(0); PG8_BAR; PG8_MMA(1, 0, At, B0); PG8_MMA(1, 1, At, B1); PG8_BAR; PG8_SCHED;
            } else {
            PG8_LDB(B0, 0, 0); PG8_SCHED; PG8_LDA(At, 0, 0); PG8_STAGE(PG8_SA(1, 1), a1 + hsA, voffA);
            PG8_WAIT_L(8); PG8_BAR; PG8_WAIT_L(0); PG8_MMA(0, 0, At, B0); PG8_BAR; PG8_SCHED;
            PG8_LDB(B1, 0, 1); PG8_STAGE(PG8_SB(0, 0), b2, voffB);
            PG8_BAR; PG8_WAIT_L(0); PG8_MMA(0, 1, At, B1); PG8_BAR;
            PG8_LDA(At, 0, 1); PG8_STAGE(PG8_SA(0, 0), a2, voffA);
            PG8_BAR; PG8_WAIT_L(0); PG8_MMA(1, 0, At, B0); PG8_BAR; PG8_SCHED;
            PG8_STAGE(PG8_SB(0, 1), b2 + hsB, voffB);
            PG8_WAIT_V(6); PG8_BAR; PG8_MMA(1, 1, At, B1); PG8_BAR;
            PG8_LDB(B0, 1, 0); PG8_SCHED; PG8_LDA(At, 1, 0); PG8_STAGE(PG8_SA(0, 1), a2 + hsA, voffA);
            PG8_WAIT_L(8); PG8_BAR; PG8_WAIT_L(0); PG8_MMA(0, 0, At, B0); PG8_BAR; PG8_SCHED;
            PG8_LDB(B1, 1, 1); PG8_STAGE(PG8_SB(1, 0), b3, voffB);
            PG8_BAR; PG8_WAIT_L(0); PG8_MMA(0, 1, At, B1); PG8_BAR;
            PG8_LDA(At, 1, 1); PG8_STAGE(PG8_SA(1, 0), a3, voffA);
            PG8_BAR; PG8_WAIT_L(0); PG8_MMA(1, 0, At, B0); PG8_BAR; PG8_SCHED;
            PG8_STAGE(PG8_SB(1, 1), b3 + hsB, voffB);
            PG8_WAIT_V(6); PG8_BAR; PG8_MMA(1, 1, At, B1); PG8_BAR;
            }
        }
        if constexpr (ALIGN_EPI) { if (wr == 0) PG8_BAR; }
        if constexpr (!Epi::AFTER_DRAIN) { const int l2 = tid_now() & 63; E(acc, cur, wr, wc, l2 & 15, l2 >> 4); S.done(cur); }
        if (!has_next) break;
#pragma unroll
        for (int a = 0; a < 2; ++a)
#pragma unroll
            for (int b = 0; b < 2; ++b)
#pragma unroll
                for (int m = 0; m < 4; ++m)
#pragma unroll
                    for (int n = 0; n < 2; ++n) acc[a][b][m][n] = (f32x4){0.f, 0.f, 0.f, 0.f};
        cur = nxt; cA = nA; cB = nB; ++ui;
        if constexpr (ALIGN_EPI) { if (wr == 1) PG8_BAR; }
    }
    PG8_WAIT_V(0);
    if constexpr (!ALIGN_EPI) { if (wr == 0) PG8_BAR; }
    PG8_BAR;
    if constexpr (Epi::AFTER_DRAIN) { const int l2 = tid_now() & 63; E.fused(acc, cur, wr, wc, l2 & 15, l2 >> 4, lds, wid, l2); S.done(cur); }
#undef PG8_SA
#undef PG8_SB
#undef PG8_STAGE
#undef PG8_LDA
#undef PG8_LDB
#undef PG8_MMA
#undef PG8_WAIT_V
#undef PG8_WAIT_L
#undef PG8_BAR
#undef PG8_SCHED
}
}
#include <hip/hip_bf16.h>
#include <cmath>
namespace attn_body {
using bf16=__hip_bfloat16;
using bf16x8=__attribute__((ext_vector_type(8)))short;
using s16x4=__attribute__((ext_vector_type(4)))short;
using f32x16=__attribute__((ext_vector_type(16)))float;
using u32x4=__attribute__((ext_vector_type(4)))unsigned;
constexpr int BATCH=8,NHEAD=8,SEQ=4096,D=64,DM=4096;
constexpr int NW=8,QBLK=32,QB=QBLK*NW,KVBLK=64,NQB=SEQ/QB;
constexpr int ATTN_PITCH=DM, ATTN_UNIT_ROWS=QB;
__device__ __forceinline__ int crow(int r,int hi){return (r&3)+8*(r>>2)+4*hi;}
#define SBAR() __builtin_amdgcn_sched_barrier(0)
__device__ __forceinline__ void cmask(f32x16&p0,f32x16&p1,int jb,int qrel,int hi){
  const float NEG=-INFINITY; int kb=64*jb+4*hi;
  #pragma unroll
  for(int r=0;r<16;++r){int kv=kb+(r&3)+8*(r>>2); if(kv>qrel)p0[r]=NEG; if(kv+32>qrel)p1[r]=NEG;}
}

constexpr int NSLOT=3, SLOTB=10240;
constexpr int LDS_K=0, LDS_V=NSLOT*SLOTB, LDS_WS=2*NSLOT*SLOTB, LDS_OST=LDS_WS+NW*64*4, LDS_BYTES=LDS_OST+NW*4096;
constexpr float C2=0.125f*1.4426950408889634f;
__device__ __forceinline__ void glds16(const void*gsrc,unsigned lds_dst){unsigned keep;
  asm volatile("s_mov_b32 %0, m0\n\ts_mov_b32 m0, %2\n\ts_nop 0\n\tglobal_load_lds_dwordx4 %1, off\n\ts_mov_b32 m0, %0":"=&s"(keep):"v"(gsrc),"s"(lds_dst):"memory");}
__device__ __forceinline__ float max3f(float a,float b,float c){float r;asm("v_max3_f32 %0, %1, %2, %3":"=v"(r):"v"(a),"v"(b),"v"(c));return r;}
__device__ __forceinline__ float max2f(float a,float b){float r;asm("v_max_f32_e32 %0, %1, %2":"=v"(r):"v"(a),"v"(b));return r;}
__device__ __forceinline__ float fadd_s(float a,float b){float r;asm("v_add_f32_e32 %0, %1, %2":"=v"(r):"v"(a),"v"(b));return r;}
__device__ __forceinline__ float fsub_s(float a,float b){float r;asm("v_sub_f32_e32 %0, %1, %2":"=v"(r):"v"(a),"v"(b));return r;}
typedef float f32x2_t __attribute__((ext_vector_type(2))); typedef __bf16 bf16x2_t __attribute__((ext_vector_type(2)));
__device__ __forceinline__ unsigned cvtpk_s(float lo,float hi){f32x2_t v={lo,hi};bf16x2_t b=__builtin_convertvector(v,bf16x2_t);return __builtin_bit_cast(unsigned,b);}
#define WAIT_BAR(N) asm volatile("s_waitcnt vmcnt(" #N ") lgkmcnt(0)\n\ts_barrier":::"memory")

#define MFX(a,b,c) __builtin_amdgcn_mfma_f32_32x32x8bf16_1k(a,b,c,0,0,0)
__device__ __forceinline__ void qkt(f32x16&p0,f32x16&p1,const char*Kslot,const bf16x8*qr,const s16x4 qx,const f32x16&negm,int r32,int hi){
  const char*kb=Kslot+hi*1024+r32*16;
  #pragma unroll
  for(int d0=0;d0<4;++d0){
    const bf16x8 b0=*reinterpret_cast<const bf16x8*>(kb+d0*2048);
    const bf16x8 b1=*reinterpret_cast<const bf16x8*>(kb+d0*2048+512);
    if(d0==0){p0=__builtin_amdgcn_mfma_f32_32x32x16_bf16(b0,qr[0],negm,0,0,0);p1=__builtin_amdgcn_mfma_f32_32x32x16_bf16(b1,qr[0],negm,0,0,0);}
    else{p0=__builtin_amdgcn_mfma_f32_32x32x16_bf16(b0,qr[d0],p0,0,0,0);p1=__builtin_amdgcn_mfma_f32_32x32x16_bf16(b1,qr[d0],p1,0,0,0);}}
  { const s16x4 x0=*reinterpret_cast<const s16x4*>(kb+8192), x1=*reinterpret_cast<const s16x4*>(kb+8192+512); p0=MFX(x0,qx,p0); p1=MFX(x1,qx,p1); }
}
typedef __attribute__((address_space(3))) const char* lds_cptr;
typedef short v4i16_t __attribute__((ext_vector_type(4)));
__device__ __forceinline__ void kload8(bf16x8*kf,lds_cptr kp){
  kf[0]=*(const __attribute__((address_space(3))) bf16x8*)(kp);      kf[1]=*(const __attribute__((address_space(3))) bf16x8*)(kp+512);
  kf[2]=*(const __attribute__((address_space(3))) bf16x8*)(kp+2048); kf[3]=*(const __attribute__((address_space(3))) bf16x8*)(kp+2560);
  kf[4]=*(const __attribute__((address_space(3))) bf16x8*)(kp+4096); kf[5]=*(const __attribute__((address_space(3))) bf16x8*)(kp+4608);
  kf[6]=*(const __attribute__((address_space(3))) bf16x8*)(kp+6144); kf[7]=*(const __attribute__((address_space(3))) bf16x8*)(kp+6656);
}
__device__ __forceinline__ void kloadx(s16x4*kx,lds_cptr kp){ kx[0]=*(const __attribute__((address_space(3))) s16x4*)(kp+8192); kx[1]=*(const __attribute__((address_space(3))) s16x4*)(kp+8192+512); }
__device__ __forceinline__ void kload2(bf16x8*kf,lds_cptr kp,int j){ kf[2*j]=*(const __attribute__((address_space(3))) bf16x8*)(kp+j*2048); kf[2*j+1]=*(const __attribute__((address_space(3))) bf16x8*)(kp+j*2048+512); }
__device__ __forceinline__ s16x4 vtr(lds_cptr p){ return __builtin_bit_cast(s16x4,__builtin_amdgcn_ds_read_tr16_b64_v4i16((__attribute__((address_space(3))) v4i16_t*)p)); }
__device__ __forceinline__ float rowmax(const f32x16&p0,const f32x16&p1){
  float a=max3f(p0[0],p0[1],p1[0]),b=max3f(p0[2],p0[3],p1[1]);a=max3f(a,p1[2],p1[3]);
  #pragma unroll
  for(int r=4;r<16;r+=4){a=max3f(a,p0[r],p0[r+1]);b=max3f(b,p0[r+2],p0[r+3]);a=max3f(a,p1[r],p1[r+1]);b=max3f(b,p1[r+2],p1[r+3]);}
  const float m=max2f(a,b);
  auto rr=__builtin_amdgcn_permlane32_swap(__float_as_uint(m),__float_as_uint(m),false,false);
  return max2f(__uint_as_float(rr[0]),__uint_as_float(rr[1]));
}
__device__ __forceinline__ void pv(f32x16*o,int vb,bf16x8 pa0,bf16x8 pa1,bf16x8 pa2,bf16x8 pa3){
  #pragma unroll
  for(int d0=0;d0<2;++d0){s16x4 lo[4],hi[4];
    #pragma unroll
    for(int ks=0;ks<4;++ks){
      asm volatile("ds_read_b64_tr_b16 %0,%1 offset:%c2":"=&v"(lo[ks]):"v"(vb),"i"(d0*4096+ks*1024):"memory");
      asm volatile("ds_read_b64_tr_b16 %0,%1 offset:%c2":"=&v"(hi[ks]):"v"(vb),"i"(d0*4096+ks*1024+512):"memory");}
    asm volatile("s_waitcnt lgkmcnt(0)":::"memory");SBAR();
    #define PK(k) (bf16x8){lo[k][0],lo[k][1],lo[k][2],lo[k][3],hi[k][0],hi[k][1],hi[k][2],hi[k][3]}
    o[d0]=__builtin_amdgcn_mfma_f32_32x32x16_bf16(pa0,PK(0),o[d0],0,0,0);
    o[d0]=__builtin_amdgcn_mfma_f32_32x32x16_bf16(pa1,PK(1),o[d0],0,0,0);
    o[d0]=__builtin_amdgcn_mfma_f32_32x32x16_bf16(pa2,PK(2),o[d0],0,0,0);
    o[d0]=__builtin_amdgcn_mfma_f32_32x32x16_bf16(pa3,PK(3),o[d0],0,0,0);
    #undef PK
  }
}

#ifndef ATTN_STORE16
#define ATTN_STORE16(p,v) (*(u32x4*)(p)=(v))
#endif
template<int THRL> __device__ __forceinline__ void attn_unit(int b,int h,int qb,const bf16*Q,const bf16*__restrict__ K,const bf16*__restrict__ V,bf16*O,const float*__restrict__ CQ,const bf16*__restrict__ KX,char*shm){
  const int tid=tid_now(),lane=tid&63,r32=lane&31,hi=lane>>5; const int wid=__builtin_amdgcn_readfirstlane(tid>>6);
  const long rowbase=(long)b*SEQ; const int q0=qb*QB;
  const bf16*Qw=Q+(rowbase+q0+wid*QBLK)*DM+h*D;
  const bf16*Kh=K+rowbase*DM+h*D,*Vh=V+rowbase*DM+h*D;
  const unsigned lds0=(unsigned)(uintptr_t)shm;
  float*wsf=(float*)(shm+LDS_WS)+wid*64;
  const bf16*ksrc=Kh+(long)lane*DM+wid*8;
  const bf16*kxsrc=KX+((long)(b*NHEAD+h)*SEQ+lane)*8;
  const float cqv=CQ[(long)(b*NHEAD+h)*SEQ+q0+wid*QBLK+r32];
  const bf16*vsrc=Vh+(long)(16*(wid&3)+(lane>>2))*DM+(wid>>2)*32+(lane&3)*8;
  const unsigned kdst=lds0+LDS_K+wid*1024, vdst=lds0+LDS_V+wid*1024;
  #define DMA_K(t,slot) do{ glds16(ksrc+(long)(t)*KVBLK*DM,(unsigned)__builtin_amdgcn_readfirstlane(kdst+(slot))); glds16(kxsrc+(long)(t)*KVBLK*8,(unsigned)__builtin_amdgcn_readfirstlane(lds0+LDS_K+8192+(slot))); }while(0)
  #define DMA_V(t,slot) glds16(vsrc+(long)(t)*KVBLK*DM,(unsigned)__builtin_amdgcn_readfirstlane(vdst+(slot)))
  const int vb0=(int)(lds0+LDS_V)+((lane>>4)&1)*32+(lane&3)*8+(4*hi+((lane&15)>>2))*64;
  const char*Kbase=shm+LDS_K; bf16x8 kf[8]; s16x4 kx[2];
  const lds_cptr shm3=(lds_cptr)shm; const lds_cptr kp0=shm3+LDS_K+hi*1024+r32*16; const lds_cptr vp0=shm3+LDS_V+((lane>>4)&1)*32+(lane&3)*8+(4*hi+((lane&15)>>2))*64;
  const int NT=(q0+QB)/KVBLK;
  DMA_K(0,0);DMA_V(0,0);DMA_K(1,SLOTB);
  bf16x8 qr[4];
  s16x4 qx; { const uint2 one3=make_uint2(0x3F803F80u,0x00003F80u); qx=__builtin_bit_cast(s16x4,one3); }
  #pragma unroll
  for(int d0=0;d0<4;++d0)qr[d0]=*reinterpret_cast<const bf16x8*>(&Qw[(long)r32*DM+d0*16+hi*8]);
  float l_reg=0.f;f32x16 o[2];o[0]=f32x16{};o[1]=f32x16{};f32x16 negm;
  _Pragma("unroll") for(int r=0;r<16;++r)negm[r]=cqv; asm volatile("":"+v"(negm));
  const int qrel=wid*QBLK+r32;
  #define CMASK(P0,P1,t) do{int jb_=(t)-(NT-4); if(jb_>=0)cmask(P0,P1,jb_,qrel,hi);}while(0)
  bool resc=false;
  #define START(P0,P1) do{ const float rm=rowmax(P0,P1); resc=false; \
    { const float dl=rm; \
      _Pragma("unroll") for(int r=0;r<16;++r){P0[r]=fsub_s(P0[r],dl);P1[r]=fsub_s(P1[r],dl);} \
      _Pragma("unroll") for(int r=0;r<16;++r)negm[r]=fsub_s(negm[r],dl); asm volatile("":"+v"(negm)); } \
    _Pragma("unroll") for(int r=0;r<16;++r)P0[r]=__builtin_amdgcn_exp2f(P0[r]); }while(0)
  #define RESC() do{ if(resc){ asm volatile("s_waitcnt lgkmcnt(0)":::"memory"); \
      _Pragma("unroll") for(int d_=0;d_<2;++d_) _Pragma("unroll") for(int r=0;r<16;++r)o[d_][r]*=wsf[crow(r,hi)]; } }while(0)
  f32x16 pA0,pA1,pB0,pB1;
  int sl_prev=0,sl_cur=0,sl_next=SLOTB;
  #define ROT() do{sl_prev=sl_cur;sl_cur=sl_next;sl_next=(sl_next==(NSLOT-1)*SLOTB)?0:sl_next+SLOTB;}while(0)
  DMA_K(2,2*SLOTB);
  WAIT_BAR(5);
  qkt(pA0,pA1,Kbase,qr,qx,negm,r32,hi);asm volatile("s_nop 15\n\ts_nop 7":"+v"(pA0),"+v"(pA1));CMASK(pA0,pA1,0);
  START(pA0,pA1);
  _Pragma("unroll") for(int r=0;r<16;++r)pA1[r]=__builtin_amdgcn_exp2f(pA1[r]);
  WAIT_BAR(0);
  DMA_K(3,0);DMA_V(1,SLOTB);
  ROT();
  kload8(kf,kp0+sl_cur); kloadx(kx,kp0+sl_cur);
  WAIT_BAR(3);
  s16x4 vlo[8],vhi[8]; u32x4 pw0,pw1,pw2,pw3;
  #define PKW(P,B) cvtpk_s(P[B],P[B+1])
  #define PAF(k) __builtin_bit_cast(bf16x8,pw##k)
  #define VFR(i) (bf16x8){vlo[i][0],vlo[i][1],vlo[i][2],vlo[i][3],vhi[i][0],vhi[i][1],vhi[i][2],vhi[i][3]}
  #define PIN(x) asm volatile("":"+v"(x))
  #define MX3(a,b,c) __builtin_fmaxf(__builtin_fmaxf((a),(b)),(c))
  #define GAPA(MF,A0,A1,A2,A3,W0,W1,PW) do{ MF; sacc+=A0; sacc+=A1; sacc+=A2; sacc+=A3; PIN(sacc); W0; W1; PIN(PW); SBAR(); }while(0)
  #define EX(v) __builtin_amdgcn_exp2f(v)
  #define GAPB(MF,X,B) do{ MF; X[B]=EX(X[B]); X[B+1]=EX(X[B+1]); X[B+2]=EX(X[B+2]); X[B+3]=EX(X[B+3]); PIN(X); SBAR(); }while(0)
  #define VRD(i) do{ vlo[i]=vtr(vp_+(((i)>>2)*4096+((i)&3)*1024)); vhi[i]=vtr(vp_+(((i)>>2)*4096+((i)&3)*1024+512)); }while(0)
  #define KRD(G,j) do{ if(G){ kload2(kf,kp0+sl_next,j); SBAR(); } }while(0)
  #define STEP(C0,C1,P0,P1,t,GK,GV,GL) do{ SBAR(); \
    const lds_cptr vp_=vp0+sl_prev; \
    C0=MFX(kx[0],qx,negm); C1=MFX(kx[1],qx,negm); SBAR(); \
    VRD(0); SBAR(); float sacc=(P0[0]+P0[1]); \
    GAPA(C0=__builtin_amdgcn_mfma_f32_32x32x16_bf16(kf[0],qr[0],C0,0,0,0), P0[2],P0[3],P0[4],P0[5],     pw0[0]=PKW(P0,0), pw0[1]=PKW(P0,2), pw0); \
    VRD(4); SBAR(); GAPA(C1=__builtin_amdgcn_mfma_f32_32x32x16_bf16(kf[1],qr[0],C1,0,0,0), P0[6],P0[7],P0[8],P0[9],     pw0[2]=PKW(P0,4), pw0[3]=PKW(P0,6), pw0); \
    VRD(1); SBAR(); GAPA(C0=__builtin_amdgcn_mfma_f32_32x32x16_bf16(kf[2],qr[1],C0,0,0,0),   P0[10],P0[11],P0[12],P0[13], pw1[0]=PKW(P0,8), pw1[1]=PKW(P0,10), pw1); \
    VRD(5); SBAR(); GAPA(C1=__builtin_amdgcn_mfma_f32_32x32x16_bf16(kf[3],qr[1],C1,0,0,0),   P0[14],P0[15],P1[0],P1[1],   pw1[2]=PKW(P0,12),pw1[3]=PKW(P0,14), pw1); \
    VRD(2); SBAR(); GAPA(C0=__builtin_amdgcn_mfma_f32_32x32x16_bf16(kf[4],qr[2],C0,0,0,0),   P1[2],P1[3],P1[4],P1[5],     pw2[0]=PKW(P1,0), pw2[1]=PKW(P1,2), pw2); \
    VRD(6); SBAR(); GAPA(C1=__builtin_amdgcn_mfma_f32_32x32x16_bf16(kf[5],qr[2],C1,0,0,0),   P1[6],P1[7],P1[8],P1[9],     pw2[2]=PKW(P1,4), pw2[3]=PKW(P1,6), pw2); \
    VRD(3); SBAR(); GAPA(C0=__builtin_amdgcn_mfma_f32_32x32x16_bf16(kf[6],qr[3],C0,0,0,0),   P1[10],P1[11],P1[12],P1[13], pw3[0]=PKW(P1,8), pw3[1]=PKW(P1,10), pw3); \
    VRD(7); SBAR(); GAPA(C1=__builtin_amdgcn_mfma_f32_32x32x16_bf16(kf[7],qr[3],C1,0,0,0),   P1[14],P1[15],0.f,0.f,       pw3[2]=PKW(P1,12),pw3[3]=PKW(P1,14), pw3); \
    l_reg+=sacc; \
    if(GK){DMA_K((t)+3,sl_cur);} if(GV){DMA_V((t)+1,sl_next);} \
    CMASK(C0,C1,t); \
    { float a=MX3(C0[0],C0[1],C1[0]),b=MX3(C0[2],C0[3],C1[1]); a=MX3(a,C1[2],C1[3]); \
      _Pragma("unroll") for(int r=4;r<16;r+=4){a=MX3(a,C0[r],C0[r+1]);b=MX3(b,C0[r+2],C0[r+3]);a=MX3(a,C1[r],C1[r+1]);b=MX3(b,C1[r+2],C1[r+3]);} \
      float rm=__builtin_fmaxf(a,b); { auto rr=__builtin_amdgcn_permlane32_swap(__float_as_uint(rm),__float_as_uint(rm),false,false); rm=__builtin_fmaxf(__uint_as_float(rr[0]),__uint_as_float(rr[1])); } \
      resc=false; \
      if(__builtin_expect(__any(rm>(float)THRL),0)){ const float dl=__builtin_fmaxf(rm,0.f); \
        _Pragma("unroll") for(int r=0;r<16;++r){C0[r]-=dl;C1[r]-=dl;} \
        _Pragma("unroll") for(int r=0;r<16;++r)negm[r]-=dl; asm volatile("":"+v"(negm)); \
        const float f=__builtin_amdgcn_exp2f(-dl); l_reg*=f; if(hi==0)wsf[r32]=f; resc=true; } } \
    SBAR(); \
    GAPB(o[0]=__builtin_amdgcn_mfma_f32_32x32x16_bf16(PAF(0),VFR(0),o[0],0,0,0), C0,0); \
    GAPB(o[1]=__builtin_amdgcn_mfma_f32_32x32x16_bf16(PAF(0),VFR(4),o[1],0,0,0), C0,4); \
    KRD(GL,0); GAPB(o[0]=__builtin_amdgcn_mfma_f32_32x32x16_bf16(PAF(1),VFR(1),o[0],0,0,0), C0,8); \
    KRD(GL,1); GAPB(o[1]=__builtin_amdgcn_mfma_f32_32x32x16_bf16(PAF(1),VFR(5),o[1],0,0,0), C0,12); \
    KRD(GL,2); GAPB(o[0]=__builtin_amdgcn_mfma_f32_32x32x16_bf16(PAF(2),VFR(2),o[0],0,0,0), C1,0); \
    KRD(GL,3); GAPB(o[1]=__builtin_amdgcn_mfma_f32_32x32x16_bf16(PAF(2),VFR(6),o[1],0,0,0), C1,4); \
    if(GL){ kloadx(kx,kp0+sl_next); SBAR(); } GAPB(o[0]=__builtin_amdgcn_mfma_f32_32x32x16_bf16(PAF(3),VFR(3),o[0],0,0,0), C1,8); \
    GAPB(o[1]=__builtin_amdgcn_mfma_f32_32x32x16_bf16(PAF(3),VFR(7),o[1],0,0,0), C1,12); \
    }while(0)
  int t=1;
  #undef CMASK
  #define CMASK(P0,P1,t) do{}while(0)
  for(;t+5<NT;t+=2){
    STEP(pB0,pB1,pA0,pA1,t,true,true,true);     WAIT_BAR(3); RESC(); ROT();
    STEP(pA0,pA1,pB0,pB1,t+1,true,true,true);   WAIT_BAR(3); RESC(); ROT();
  }
  #undef CMASK
  #define CMASK(P0,P1,t) do{int jb_=(t)-(NT-4); if(jb_>=0)cmask(P0,P1,jb_,qrel,hi);}while(0)
  #define ENDW(tt) do{ if((tt)+3<NT){WAIT_BAR(3);} else if((tt)+2<NT){WAIT_BAR(1);} else {WAIT_BAR(0);} }while(0)
  for(;t+1<NT;t+=2){
    STEP(pB0,pB1,pA0,pA1,t,(t+3<NT),(t+1<NT),(t+1<NT));       ENDW(t);   RESC(); ROT();
    STEP(pA0,pA1,pB0,pB1,t+1,(t+4<NT),(t+2<NT),(t+2<NT));     ENDW(t+1); RESC(); ROT();
  }
  STEP(pB0,pB1,pA0,pA1,NT-1,false,false,false); RESC();
  { float sacc=pB0[0]+pB0[1]; _Pragma("unroll") for(int r=2;r<16;++r)sacc+=pB0[r]; _Pragma("unroll") for(int r=0;r<16;++r)sacc+=pB1[r]; l_reg+=sacc;
    pw0=(u32x4){PKW(pB0,0),PKW(pB0,2),PKW(pB0,4),PKW(pB0,6)};pw1=(u32x4){PKW(pB0,8),PKW(pB0,10),PKW(pB0,12),PKW(pB0,14)};pw2=(u32x4){PKW(pB1,0),PKW(pB1,2),PKW(pB1,4),PKW(pB1,6)};pw3=(u32x4){PKW(pB1,8),PKW(pB1,10),PKW(pB1,12),PKW(pB1,14)};
    SBAR(); pv(o,vb0+sl_cur,PAF(0),PAF(1),PAF(2),PAF(3)); }
  #undef PKW
  #undef PAF
  #undef VFR
  #undef PIN
  #undef MX3
  #undef GAPA
  #undef GAPB
  #undef EX
  #undef VRD
  #undef KRD
  #undef STEP
  #undef ENDW
  {auto rr=__builtin_amdgcn_permlane32_swap(__float_as_uint(l_reg),__float_as_uint(l_reg),false,false);l_reg=__uint_as_float(rr[0])+__uint_as_float(rr[1]);}
  if(hi==0)wsf[32+r32]=l_reg;asm volatile("s_waitcnt lgkmcnt(0)":::"memory");
  float rli[16];
  #pragma unroll
  for(int r=0;r<16;++r)rli[r]=__builtin_amdgcn_rcpf(wsf[32+crow(r,hi)]);
  bf16*Ow=O+(rowbase+q0+wid*QBLK)*DM+h*D;
  { bf16*stg=(bf16*)(shm+LDS_OST)+wid*2048;
    #pragma unroll
    for(int r=0;r<16;++r){const int orow=crow(r,hi);
      #pragma unroll
      for(int d0=0;d0<2;++d0)stg[orow*64+d0*32+r32]=__float2bfloat16(o[d0][r]*rli[r]);}
    asm volatile("s_waitcnt lgkmcnt(0)":::"memory");
    #pragma unroll
    for(int i=0;i<4;++i){const int row=i*8+(lane>>3),ch=lane&7; const u32x4 v=*(const u32x4*)(stg+row*64+ch*8); ATTN_STORE16(Ow+(long)row*DM+ch*8,v);} }
  asm volatile("s_waitcnt lgkmcnt(0)\n\ts_barrier":::"memory");
  #undef DMA_K
  #undef DMA_V
  #undef CMASK
  #undef START
  #undef RESC
  #undef ROT
}
constexpr int ATTN_LDS_BYTES=LDS_BYTES;
struct AttnTensors { const bf16* Q; const bf16* K; const bf16* V; bf16* O; const float* CQ; const bf16* KX; };
struct AttnUnit { int bh; int qb; };
struct StaticOrder {
  int vcu;
  __device__ __forceinline__ explicit StaticOrder(int grid,int block):vcu((block%8)*(grid/8)+block/8){}
  __device__ __forceinline__ bool next(int i,AttnUnit&u)const{ if(i>=4)return false; const int s=vcu&3; u.bh=vcu>>2; u.qb=(i==0)?s:(i==1)?7-s:(i==2)?8+s:15-s; return true; }
  __device__ __forceinline__ void a_ready(const AttnUnit&)const{}
  __device__ __forceinline__ void done(const AttnUnit&)const{}
};
template<class Sched,int THRL=8> __device__ __forceinline__ void attn_phase(char*lds,const AttnTensors&T,const Sched&S){
  AttnUnit u;
  { unsigned*z=(unsigned*)lds; for(int s=0;s<NSLOT;++s) if(threadIdx.x<256) z[(LDS_K+s*SLOTB+9216)/4+threadIdx.x]=0u; }
  asm volatile("s_waitcnt lgkmcnt(0)\n\ts_barrier":::"memory");
  for(int i=0;S.next(i,u);++i){ S.a_ready(u); attn_unit<THRL>(u.bh/NHEAD,u.bh%NHEAD,u.qb,T.Q,T.K,T.V,T.O,T.CQ,T.KX,lds); S.done(u); }
}
#undef SBAR
#undef WAIT_BAR
}
#ifndef LAYER_UNROLL
#define LAYER_UNROLL _Pragma("unroll")
#endif
constexpr int NWAVES = 8;
constexpr int M = 32768, D = 1024, NPROJ = 4096, NIN = 4104, DFF = 2816, SEQL = 4096, NB = 8, NH = 8, NLAYER = 2;
constexpr float RMS_EPS = 1e-6f;
constexpr size_t MiB = 1u << 20;
constexpr size_t WS_MOD = 1 * MiB, WS_WF = 1 * MiB + 512 * 1024, WS_LAMT = 1 * MiB + 768 * 1024, WS_LF = 2 * MiB, WS_CQ = 3 * MiB, WS_KX = 4 * MiB, WS_W = 8 * MiB;
constexpr size_t W_IN = 0, W_GLU = 8 * MiB, W_MG = W_GLU + MiB / 2, W_O = W_MG + 2 * MiB, W_GU = W_O + 2 * MiB, W_DN = W_GU + 11 * MiB, W_G1 = W_DN + 11 * MiB / 2, W_S5W = W_G1 + 6 * MiB, W_LAYER = W_S5W + 4 * MiB;
constexpr size_t WS_XN = 88 * MiB, WS_PROJ = 152 * MiB, WS_HH = 152 * MiB, WS_Y = 328 * MiB, WS_ING = 408 * MiB, WS_Z = 456 * MiB, WS_MG = 408 * MiB, WS_END = 488 * MiB;
static_assert(WS_W + 2 * W_LAYER <= WS_XN, "weights fit");
constexpr int RING_OFF = 0, RING_BYTES = 131072, LDSCTL_OFF = 139264, LDS_BYTES = 147456;
#define LAS __attribute__((address_space(3)))
typedef unsigned short bf16;
typedef unsigned v4u __attribute__((ext_vector_type(4)));
typedef float f32x4 __attribute__((ext_vector_type(4)));
#define LDS_WAIT() asm volatile("s_waitcnt lgkmcnt(0)" ::: "memory")
__device__ __forceinline__ unsigned f2bf(float f) { unsigned u = __builtin_bit_cast(unsigned, f); return (u + 0x7fffu + ((u >> 16) & 1u)) >> 16; }
__device__ __forceinline__ unsigned pk2(float lo, float hi) { return f2bf(lo) | (f2bf(hi) << 16); }
__device__ __forceinline__ float bf2f(unsigned b) { return __uint_as_float(b << 16); }
__device__ __forceinline__ float wave_sum(float v) {
#pragma unroll
    for (int o = 1; o < 64; o <<= 1) v += __shfl_xor(v, o);
    return v;
}
struct Args { const float* in[26]; float* out; unsigned char* ws; int ph_lo, ph_hi; };
typedef const __attribute__((address_space(4))) char* kptr_t;
__device__ __forceinline__ const float* arg_ptr(int i) { kptr_t k = (kptr_t)__builtin_amdgcn_kernarg_segment_ptr(); asm volatile("" : "+s"(k)); return *(const float* const __attribute__((address_space(4)))*)(k + 8 * i); }
#define AIN(i) arg_ptr(i)
#define AOUT ((float*)arg_ptr(26))
#define AWS ((unsigned char*)arg_ptr(27))
enum { I_X = 0, I_C, I_WADA, I_BADA, I_GPREMIX, I_GPOSTMIX, I_GPREFFN, I_GPOSTFFN, I_WIN, I_LAMRE, I_LAMIM, I_LOGDT, I_BRE, I_BIM, I_CRE, I_CIM, I_DSKIP, I_WGLU, I_BGLU, I_BF, I_WPA, I_WPB, I_WO, I_WGATE, I_WUP, I_WDOWN };

__device__ __forceinline__ void tr_item(const float* W, int ldw, int k0, int c0, bf16* WT, int ldd, int drow0, int kofs, LAS float* scr, int lane) {
#pragma unroll 8
    for (int i = 0; i < 32; ++i) { const int kk = 2 * i + (lane >> 5); scr[kk * 33 + (lane & 31)] = W[(size_t)(k0 + kk) * ldw + c0 + (lane & 31)]; }
    LDS_WAIT(); asm volatile("" ::: "memory");
    const int c = lane & 7;
#pragma unroll
    for (int j = 0; j < 4; ++j) { const int n = (lane >> 3) + 8 * j; const LAS float* s = scr + (8 * c) * 33 + n;
        v4u o; o.x = pk2(s[0 * 33], s[1 * 33]); o.y = pk2(s[2 * 33], s[3 * 33]); o.z = pk2(s[4 * 33], s[5 * 33]); o.w = pk2(s[6 * 33], s[7 * 33]);
        *(v4u*)(WT + (size_t)(drow0 + n) * ldd + kofs + k0 + 8 * c) = o; }
    LDS_WAIT(); asm volatile("" ::: "memory");
}
constexpr int TI_WIN = 16 * 64, TI_GLU = 8 * 16, TI_PA = 8 * 32, TI_O = 16 * 32, TI_FF = 16 * 88, TI_DN = 44 * 32;
constexpr int TI_LAYER = 2 * TI_WIN + TI_GLU + 2 * TI_PA + TI_O + 2 * TI_FF + TI_DN;
__device__ __forceinline__ void p0_transposes(const Args& a, LAS unsigned char* lds, int gw, int ngw, int wave, int lane) {
    LAS float* scr = (LAS float*)(lds + wave * 16384);
    for (int it = gw; it < NLAYER * TI_LAYER; it += ngw) {
        const int l = it / TI_LAYER; int r = it % TI_LAYER;
        bf16* wb = (bf16*)(AWS + WS_W + (size_t)l * W_LAYER);
        if (r < 2 * TI_WIN) { const int seg = r / TI_WIN; r %= TI_WIN; const int kb = r / 64, nb = r % 64;
            tr_item(AIN(I_WIN) + (size_t)l * D * NIN, NIN, 64 * kb, seg * 2056 + 32 * nb, (bf16*)((unsigned char*)wb + W_IN), D, seg * 2048 + 32 * nb, 0, scr, lane); continue; } r -= 2 * TI_WIN;
        if (r < TI_GLU) { const int kb = r / 16, nb = r % 16; tr_item(AIN(I_WGLU) + (size_t)l * 512 * 512, 512, 64 * kb, 32 * nb, (bf16*)((unsigned char*)wb + W_GLU), 512, 32 * nb, 0, scr, lane); continue; } r -= TI_GLU;
        if (r < 2 * TI_PA) { const int seg = r / TI_PA; r %= TI_PA; const int kb = r / 32, nb = r % 32;
            tr_item(AIN(seg ? I_WPB : I_WPA) + (size_t)l * 512 * D, D, 64 * kb, 32 * nb, (bf16*)((unsigned char*)wb + W_MG), D, 32 * nb, seg * 512, scr, lane); continue; } r -= 2 * TI_PA;
        if (r < TI_O) { const int kb = r / 32, nb = r % 32; tr_item(AIN(I_WO) + (size_t)l * D * D, D, 64 * kb, 32 * nb, (bf16*)((unsigned char*)wb + W_O), D, 32 * nb, 0, scr, lane); continue; } r -= TI_O;
        if (r < 2 * TI_FF) { const int seg = r / TI_FF; r %= TI_FF; const int kb = r / 88, nb = r % 88; const int n0 = 32 * nb;
            tr_item(AIN(seg ? I_WUP : I_WGATE) + (size_t)l * D * DFF, DFF, 64 * kb, n0, (bf16*)((unsigned char*)wb + W_GU), D, (n0 / 128) * 256 + (n0 % 128) + seg * 128, 0, scr, lane); continue; } r -= 2 * TI_FF;
        { const int kb = r / 32, nb = r % 32; tr_item(AIN(I_WDOWN) + (size_t)l * DFF * D, D, 64 * kb, 32 * nb, (bf16*)((unsigned char*)wb + W_DN), DFF, 32 * nb, 0, scr, lane); }
    }
}
__device__ __forceinline__ void p0_mod(const Args& a, LAS unsigned char* lds, int tid, int wave, int lane, int bx, int G) {
    LAS float* sc = (LAS float*)lds;
    LAS float* part = (LAS float*)(lds + 32768);
    const float* c = AIN(I_C);
    for (int i = tid; i < NB * D; i += 512) { const float v = c[i]; sc[i] = v / (1.0f + __expf(-v)); }
    __syncthreads();
    float* MOD = (float*)(AWS + WS_MOD);
    for (int it = bx; it < NLAYER * 96; it += G) {
        const int l = it / 96, col = (it % 96) * 64 + lane;
        const float* w = AIN(I_WADA) + (size_t)l * D * 6144 + col;
        float acc[8] = {0.f, 0.f, 0.f, 0.f, 0.f, 0.f, 0.f, 0.f};
#pragma unroll 4
        for (int k = 128 * wave; k < 128 * wave + 128; ++k) { const float wv = w[(size_t)k * 6144];
#pragma unroll
            for (int b = 0; b < 8; ++b) acc[b] += sc[b * D + k] * wv; }
#pragma unroll
        for (int b = 0; b < 8; ++b) part[(wave * 8 + b) * 64 + lane] = acc[b];
        __syncthreads();
        { const int b = tid >> 6; float s = 0.f;
#pragma unroll
          for (int w8 = 0; w8 < 8; ++w8) s += part[(w8 * 8 + b) * 64 + lane];
          MOD[((size_t)l * 8 + b) * 6144 + col] = s + AIN(I_BADA)[(size_t)l * 6144 + col]; }
        __syncthreads();
    }
}
__device__ __forceinline__ void p0_s5(const Args& a, LAS unsigned char* lds, int tid, int it) {
    const int l = it >> 5, g = it & 31;
    LAS float* LB = (LAS float*)lds;
    LAS float* BB = LB + 64 * 17 * 2;
    LAS float* CC = BB + 64 * 16 * 2;
    LAS float* FAC = CC + 16 * 64 * 2;
    LAS float* KERN = FAC + 128;
    const size_t lg = (size_t)l * 32 + g;
    if (tid < 64) { const int p = tid;
        const float lre = fminf(AIN(I_LAMRE)[lg * 64 + p], -1e-4f), lim = AIN(I_LAMIM)[lg * 64 + p], dt = __expf(AIN(I_LOGDT)[lg]);
        const float mag = expf(lre * dt), th = lim * dt, kk = rintf(th * 0.15915494309189535f);
        float rr = fmaf(-kk, 6.2831854820251465f, th); rr = fmaf(kk, 1.7484556e-7f, rr);
        const float br = mag * cosf(rr), bi = mag * sinf(rr);
        float pr = 1.f, pi = 0.f;
        for (int d = 0; d <= 16; ++d) { LB[(p * 17 + d) * 2] = pr; LB[(p * 17 + d) * 2 + 1] = pi; const float nr = pr * br - pi * bi, ni = pr * bi + pi * br; pr = nr; pi = ni; }
        const float nr = br - 1.f, ni = bi, den = lre * lre + lim * lim;
        FAC[2 * p] = (nr * lre + ni * lim) / den; FAC[2 * p + 1] = (ni * lre - nr * lim) / den;
        float* LT = (float*)(AWS + WS_LAMT) + (lg * 64 + p) * 2; LT[0] = LB[(p * 17 + 16) * 2]; LT[1] = LB[(p * 17 + 16) * 2 + 1];
    }
    __syncthreads();
    for (int i = tid; i < 1024; i += 512) { const int p = i >> 4;
        const float br = AIN(I_BRE)[lg * 1024 + i], bi = AIN(I_BIM)[lg * 1024 + i], fr = FAC[2 * p], fi = FAC[2 * p + 1];
        BB[2 * i] = fr * br - fi * bi; BB[2 * i + 1] = fr * bi + fi * br;
        CC[2 * i] = AIN(I_CRE)[lg * 1024 + i]; CC[2 * i + 1] = AIN(I_CIM)[lg * 1024 + i]; }
    __syncthreads();
    for (int i = tid; i < 4096; i += 512) { const int d = i >> 8, ho = (i >> 4) & 15, hi = i & 15; float s = 0.f;
        for (int p = 0; p < 64; ++p) { const float cr = CC[(ho * 64 + p) * 2], ci = CC[(ho * 64 + p) * 2 + 1], lr = LB[(p * 17 + d) * 2], li = LB[(p * 17 + d) * 2 + 1], br = BB[(p * 16 + hi) * 2], bi = BB[(p * 16 + hi) * 2 + 1];
            const float tr = cr * lr - ci * li, ti = cr * li + ci * lr; s += tr * br - ti * bi; }
        KERN[i] = s; }
    __syncthreads();
    bf16* G1 = (bf16*)(AWS + WS_W + (size_t)l * W_LAYER + W_G1) + (size_t)g * 256 * 384;
    bf16* SW = (bf16*)(AWS + WS_W + (size_t)l * W_LAYER + W_S5W) + (size_t)g * 256 * 256;
    for (int i = tid; i < 256 * 192; i += 512) { const int n = i / 192, c2 = (i % 192) * 2, t = n >> 4, ho = n & 15; float v[2];
#pragma unroll
        for (int e = 0; e < 2; ++e) { const int col = c2 + e;
            if (col < 256) { const int s = col >> 4, hi = col & 15; v[e] = (t >= s) ? KERN[((t - s) * 16 + ho) * 16 + hi] : 0.f; }
            else { const int p = (col - 256) >> 1, ri = col & 1; const float cr = CC[(ho * 64 + p) * 2], ci = CC[(ho * 64 + p) * 2 + 1], lr = LB[(p * 17 + t + 1) * 2], li = LB[(p * 17 + t + 1) * 2 + 1];
                v[e] = ri ? -(cr * li + ci * lr) : (cr * lr - ci * li); } }
        *(unsigned*)(G1 + (size_t)n * 384 + c2) = pk2(v[0], v[1]); }
    for (int i = tid; i < 256 * 128; i += 512) { const int n = i >> 7, c2 = (i & 127) * 2; float v[2];
#pragma unroll
        for (int e = 0; e < 2; ++e) { const int col = c2 + e, s = col >> 4, hi = col & 15;
            if (n < 128) { const int p = n >> 1, ri = n & 1; const float lr = LB[(p * 17 + 15 - s) * 2], li = LB[(p * 17 + 15 - s) * 2 + 1], br = BB[(p * 16 + hi) * 2], bi = BB[(p * 16 + hi) * 2 + 1];
                v[e] = ri ? (lr * bi + li * br) : (lr * br - li * bi); } else v[e] = 0.f; }
        *(unsigned*)(SW + (size_t)n * 256 + c2) = pk2(v[0], v[1]); }
    __syncthreads();
}
struct RN { const float* xin; const bf16* y; float* xout; const float* gate; const float* gpost; const float* gpre; const float* scale; const float* shift; bf16* xn; const float* bf; float* lf; };
__device__ __forceinline__ void resnorm_phase(const RN& P, const float* wf_g, LAS unsigned char* lds, int tid, int wave, int lane, int gw, int ngw) {
    LAS float* WFL = (LAS float*)lds;
    if (P.lf) { for (int i = tid; i < 2048; i += 512) ((LAS f32x4*)WFL)[i] = ((const f32x4*)wf_g)[i]; __syncthreads(); }
    for (int m = gw; m < M; m += ngw) {
        const int b = m >> 12;
        f32x4 v[4];
#pragma unroll
        for (int j = 0; j < 4; ++j) v[j] = *((const f32x4*)(P.xin + (size_t)m * D) + lane + 64 * j);
        if (P.y) {
            f32x4 yy[4]; float s = 0.f;
#pragma unroll
            for (int j = 0; j < 4; ++j) { const uint2 w = *((const uint2*)(P.y + (size_t)m * D) + lane + 64 * j); yy[j] = (f32x4){bf2f(w.x & 0xffffu), bf2f(w.x >> 16), bf2f(w.y & 0xffffu), bf2f(w.y >> 16)};
                s += (yy[j].x * yy[j].x + yy[j].y * yy[j].y) + (yy[j].z * yy[j].z + yy[j].w * yy[j].w); }
            const float rstd = rsqrtf(wave_sum(s) * (1.f / D) + RMS_EPS);
#pragma unroll
            for (int j = 0; j < 4; ++j) { const f32x4 gt = *((const f32x4*)(P.gate + (size_t)b * 6144) + lane + 64 * j), gp = *((const f32x4*)P.gpost + lane + 64 * j);
                v[j] = v[j] + gt * (yy[j] * rstd * gp); *((f32x4*)(P.xout + (size_t)m * D) + lane + 64 * j) = v[j]; }
        }
        if (P.gpre) {
            float s = 0.f;
#pragma unroll
            for (int j = 0; j < 4; ++j) s += (v[j].x * v[j].x + v[j].y * v[j].y) + (v[j].z * v[j].z + v[j].w * v[j].w);
            const float rstd = rsqrtf(wave_sum(s) * (1.f / D) + RMS_EPS);
            float fa[8] = {0.f, 0.f, 0.f, 0.f, 0.f, 0.f, 0.f, 0.f};
#pragma unroll
            for (int j = 0; j < 4; ++j) { const f32x4 gp = *((const f32x4*)P.gpre + lane + 64 * j), sc = *((const f32x4*)(P.scale + (size_t)b * 6144) + lane + 64 * j), sh = *((const f32x4*)(P.shift + (size_t)b * 6144) + lane + 64 * j);
                const f32x4 h = v[j] * rstd * gp * (sc + 1.0f) + sh;
                *((uint2*)(P.xn + (size_t)m * D) + lane + 64 * j) = make_uint2(pk2(h.x, h.y), pk2(h.z, h.w));
                if (P.lf) {
#pragma unroll
                    for (int i = 0; i < 4; ++i) { const LAS f32x4* wp = (const LAS f32x4*)(WFL + (size_t)(256 * j + 4 * lane + i) * 8); const f32x4 w0 = wp[0], w1 = wp[1]; const float hv = h[i];
                        fa[0] += hv * w0.x; fa[1] += hv * w0.y; fa[2] += hv * w0.z; fa[3] += hv * w0.w; fa[4] += hv * w1.x; fa[5] += hv * w1.y; fa[6] += hv * w1.z; fa[7] += hv * w1.w; } } }
            if (P.lf) {
#pragma unroll
                for (int q = 0; q < 8; ++q) fa[q] = wave_sum(fa[q]);
                if (lane < 8) { float f = fa[0];
#pragma unroll
                    for (int q = 1; q < 8; ++q) f = (lane == q) ? fa[q] : f;
                    const float vv = f + P.bf[lane]; P.lf[(size_t)m * 8 + lane] = fminf(vv, 0.f) - __logf(1.0f + __expf(-fabsf(vv))); } }
        }
    }
}
__device__ __forceinline__ void cumsum_item(const Args& a, LAS unsigned char* lds, int tid, int wave, int lane, int it) {
    const int b = it >> 3, hh = it & 7;
    const float* LF = (const float*)(AWS + WS_LF); float* CQ = (float*)(AWS + WS_CQ); v4u* KX = (v4u*)(AWS + WS_KX);
    LAS double* sh = (LAS double*)lds;
    double v[8], tot = 0.0;
#pragma unroll
    for (int i = 0; i < 8; ++i) { v[i] = (double)LF[((size_t)b * SEQL + 8 * tid + i) * 8 + hh]; tot += v[i]; }
    double inc = tot;
#pragma unroll
    for (int o = 1; o < 64; o <<= 1) { const double t = __shfl_up(inc, o); if (lane >= o) inc += t; }
    if (lane == 63) sh[wave] = inc;
    __syncthreads();
    double run = inc - tot;
    for (int w = 0; w < wave; ++w) run += sh[w];
#pragma unroll
    for (int i = 0; i < 8; ++i) { run += v[i]; const float c2 = (float)(run * 1.4426950408889634);
        const size_t idx = ((size_t)(b * NH + hh)) * SEQL + 8 * tid + i; CQ[idx] = c2;
        const float nv = -c2; const unsigned h1 = f2bf(nv); const float r1 = nv - bf2f(h1); const unsigned h2 = f2bf(r1); const float r2 = r1 - bf2f(h2); const unsigned h3 = f2bf(r2);
        KX[idx] = (v4u){h1 | (h2 << 16), h3, 0u, 0u}; }
    __syncthreads();
}

__global__ void __launch_bounds__(NWAVES * 64, 2) mk_fwd(Args a) {
    extern __shared__ __attribute__((aligned(16))) unsigned char lds_raw[];
    cg::grid_group grid = cg::this_grid();
    LAS unsigned char* lds = (LAS unsigned char*)lds_raw;
#define TID_DEFS const int tid = tid_now(), lane = tid & 63, wave = __builtin_amdgcn_readfirstlane(tid >> 6); const int gw = vcu * NWAVES + wave, ngw = G * NWAVES; (void)gw; (void)ngw; (void)lane
    const int G = gridDim.x, bx = blockIdx.x;
    const int vcu = (G % 8 == 0) ? (bx % 8) * (G / 8) + bx / 8 : bx;
#define WS_DEFS unsigned char* ws = AWS; float* MOD = (float*)(ws + WS_MOD); bf16* XN = (bf16*)(ws + WS_XN); bf16* PROJ = (bf16*)(ws + WS_PROJ); bf16* HH = (bf16*)(ws + WS_HH); bf16* YB = (bf16*)(ws + WS_Y); \
    bf16* ING = (bf16*)(ws + WS_ING); bf16* ZB = (bf16*)(ws + WS_Z); bf16* MG = (bf16*)(ws + WS_MG); (void)MOD; (void)XN; (void)PROJ; (void)HH; (void)YB; (void)ING; (void)ZB; (void)MG
#ifndef PHASE_MASK
#define PHASE_MASK 0x7ff
#endif
#define IN(p) (a.ph_lo <= (p) && (p) < a.ph_hi)
#define EN(k) (((PHASE_MASK) >> (k)) & 1)
#define SEAM(p) do { if (IN(p) && IN((p) + 1)) grid.sync(); } while (0)
    if (EN(9) && IN(0)) {
        TID_DEFS; WS_DEFS;
        p0_mod(a, lds, tid, wave, lane, bx, G);
        for (int it = G - 1 - bx; it < NLAYER * 32; it += G) p0_s5(a, lds, tid, it);
        __syncthreads();
        p0_transposes(a, lds, gw, ngw, wave, lane);
        for (int i = bx * 512 + tid; i < NLAYER * D * 8; i += G * 512) { const int l = i / (D * 8), r = i % (D * 8); ((float*)(ws + WS_WF))[i] = AIN(I_WIN)[(size_t)l * D * NIN + (size_t)(r >> 3) * NIN + 2048 + (r & 7)]; }
    }
    SEAM(0);
    if (EN(10) && IN(1)) {
        TID_DEFS; WS_DEFS;
        RN P{AIN(I_X), nullptr, nullptr, nullptr, nullptr, AIN(I_GPREMIX), MOD + 1024, MOD, XN, AIN(I_BF), (float*)(ws + WS_LF)};
        resnorm_phase(P, (const float*)(ws + WS_WF), lds, tid, wave, lane, gw, ngw);
    }
    SEAM(1);
    LAYER_UNROLL
    for (int l = 0; l < NLAYER; ++l) {
        const int pb = 2 + 9 * l;
#define L_DEFS WS_DEFS; unsigned char* wb = ws + WS_W + (size_t)l * W_LAYER; const float* modl = MOD + (size_t)l * 8 * 6144; (void)wb; (void)modl
        if (EN(0) && IN(pb + 0)) {
            TID_DEFS;
            L_DEFS;
            for (int it = bx; it < NB * NH; it += G) cumsum_item(a, lds, tid, wave, lane, it);
            pg8::Gemm g{XN, (const bf16*)(wb + W_IN), D, D, D}; pg8::StaticOrder S; S.init(M, NPROJ, G, bx);
            pg8::EpiWin E{PROJ, ING, attn_body::C2};
            pg8::gemm_phase<pg8::EpiWin, pg8::StaticOrder, true, true>(lds + RING_OFF, g, S, E);
        }
        SEAM(pb + 0);
        if (EN(1) && IN(pb + 1)) {
            L_DEFS;
#ifndef NO_S5
            if (bx < 256) { const int g5 = bx >> 3, b5 = bx & 7;
                pg8::OneUnit S{g5 * 8 + b5, g5};
                { pg8::Gemm g{ING, (const bf16*)(wb + W_S5W), 256, 384, 256}; pg8::EpiS5E E{ING, (const float*)(ws + WS_LAMT) + ((size_t)l * 32 + g5) * 128};
                  pg8::gemm_phase<pg8::EpiS5E, pg8::OneUnit, false, true>(lds + RING_OFF, g, S, E); }
                { pg8::Gemm g{ING, (const bf16*)(wb + W_G1), 384, 384, 384}; pg8::EpiS5Main E{ING, AIN(I_DSKIP) + (size_t)l * 512, ZB};
                  pg8::gemm_phase<pg8::EpiS5Main, pg8::OneUnit, false, true>(lds + RING_OFF, g, S, E); } }
#endif
            __syncthreads();
            const attn_body::AttnTensors AT{(const attn_body::bf16*)(PROJ + 512), (const attn_body::bf16*)(PROJ + 1024), (const attn_body::bf16*)(PROJ + 1536), (attn_body::bf16*)(PROJ + 512), (const float*)(ws + WS_CQ), (const attn_body::bf16*)(ws + WS_KX)};
            const attn_body::StaticOrder S(G, bx);
#ifndef NO_ATTN
            attn_body::attn_phase<attn_body::StaticOrder>((char*)lds_raw + RING_OFF, AT, S);
#endif
        }
        SEAM(pb + 1);
        if (EN(2) && IN(pb + 2)) {
            L_DEFS;
            pg8::Gemm g{ZB, (const bf16*)(wb + W_GLU), 512, 512, 512}; pg8::StaticOrder S; S.init(M, 512, G, bx);
            pg8::EpiGlu E{ZB, AIN(I_BGLU) + (size_t)l * 512, PROJ};
            pg8::gemm_phase<pg8::EpiGlu, pg8::StaticOrder, true, true>(lds + RING_OFF, g, S, E);
        }
        SEAM(pb + 2);
        if (EN(3) && IN(pb + 3)) {
            L_DEFS;
            pg8::Gemm g{PROJ, (const bf16*)(wb + W_MG), D, NPROJ, D}; pg8::StaticOrder S; S.init(M, D, G, bx);
            pg8::EpiMerge E{PROJ, MG, 8};
            pg8::gemm_phase<pg8::EpiMerge, pg8::StaticOrder, true, true>(lds + RING_OFF, g, S, E);
        }
        SEAM(pb + 3);
        if (EN(4) && IN(pb + 4)) {
            L_DEFS;
            pg8::Gemm g{MG, (const bf16*)(wb + W_O), D, D, D}; pg8::StaticOrder S; S.init(M, D, G, bx);
            pg8::EpiBf16<0> E{YB, D, nullptr, 0, 0, 1.f};
            pg8::gemm_phase<pg8::EpiBf16<0>, pg8::StaticOrder, true, true>(lds + RING_OFF, g, S, E);
        }
        SEAM(pb + 4);
        if (EN(5) && IN(pb + 5)) {
            TID_DEFS;
            L_DEFS;
            RN P{l == 0 ? AIN(I_X) : AOUT, YB, AOUT, modl + 2048, AIN(I_GPOSTMIX) + (size_t)l * D, AIN(I_GPREFFN) + (size_t)l * D, modl + 4096, modl + 3072, XN, nullptr, nullptr};
            resnorm_phase(P, nullptr, lds, tid, wave, lane, gw, ngw);
        }
        SEAM(pb + 5);
        if (EN(6) && IN(pb + 6)) {
            L_DEFS;
            pg8::Gemm g{XN, (const bf16*)(wb + W_GU), D, D, D}; pg8::StaticOrder S; S.init(M, 2 * DFF, G, bx);
            pg8::EpiSwiglu E{HH};
            pg8::gemm_phase<pg8::EpiSwiglu, pg8::StaticOrder, true, true>(lds + RING_OFF, g, S, E);
        }
        SEAM(pb + 6);
        if (EN(7) && IN(pb + 7)) {
            L_DEFS;
            pg8::Gemm g{HH, (const bf16*)(wb + W_DN), DFF, DFF, DFF}; pg8::StaticOrder S; S.init(M, D, G, bx);
            pg8::EpiBf16<0> E{YB, D, nullptr, 0, 0, 1.f};
            pg8::gemm_phase<pg8::EpiBf16<0>, pg8::StaticOrder, true, true>(lds + RING_OFF, g, S, E);
        }
        SEAM(pb + 7);
        if (EN(8) && IN(pb + 8)) {
            TID_DEFS;
            L_DEFS;
            const bool nx = (l + 1 < NLAYER); const float* modn = MOD + (size_t)(l + 1) * 8 * 6144;
            RN P{AOUT, YB, AOUT, modl + 5120, AIN(I_GPOSTFFN) + (size_t)l * D, nx ? AIN(I_GPREMIX) + (size_t)(l + 1) * D : nullptr, nx ? modn + 1024 : nullptr, nx ? modn : nullptr, XN, nx ? AIN(I_BF) + (size_t)(l + 1) * 8 : nullptr, nx ? (float*)(ws + WS_LF) : nullptr};
            resnorm_phase(P, (const float*)(ws + WS_WF) + (size_t)(l + 1) * D * 8, lds, tid, wave, lane, gw, ngw);
        }
        SEAM(pb + 8);
    }
}

extern "C" void kernel_launch(void* const* d_in, const int* in_sizes, int n_in, void* d_out, int out_size, void* d_ws, size_t ws_size, hipStream_t stream) {
    static int grid = 0;
    if (grid == 0) {
        if (n_in != 26 || out_size != M * D || ws_size < WS_END) { fprintf(stderr, "kernel_launch: unexpected problem: n_in %d out %d ws %zu (need %zu)\n", n_in, out_size, ws_size, (size_t)WS_END); grid = -1; return; }
        int dev = 0, cus = 0, per_cu = 0;
        hipGetDevice(&dev); hipDeviceGetAttribute(&cus, hipDeviceAttributeMultiprocessorCount, dev);
        if (hipFuncSetAttribute((const void*)mk_fwd, hipFuncAttributeMaxDynamicSharedMemorySize, LDS_BYTES) != hipSuccess) { fprintf(stderr, "kernel_launch: hipFuncSetAttribute failed\n"); grid = -1; return; }
        hipOccupancyMaxActiveBlocksPerMultiprocessor(&per_cu, (const void*)mk_fwd, NWAVES * 64, LDS_BYTES);
        (void)hipGetLastError();
        if (per_cu < 1) per_cu = 1;
        grid = cus * per_cu;
        if (grid != 256) fprintf(stderr, "kernel_launch: grid %d (cus %d x %d): this kernel is laid out for 256 workgroups\n", grid, cus, per_cu);
    }
    if (grid < 0) return;
    Args a{};
    for (int i = 0; i < 26; ++i) a.in[i] = (const float*)d_in[i];
    a.out = (float*)d_out; a.ws = (unsigned char*)d_ws;
#ifndef MK_SPLIT
    a.ph_lo = 0; a.ph_hi = 2 + 9 * NLAYER;
    void* args[] = {&a};
    hipError_t e = hipLaunchCooperativeKernel((const void*)mk_fwd, dim3(grid), dim3(NWAVES * 64), args, LDS_BYTES, stream);
    if (e != hipSuccess) fprintf(stderr, "kernel_launch: cooperative launch failed: %s (grid %d)\n", hipGetErrorString(e), grid);
#else
    for (int ph = 0; ph < 2 + 9 * NLAYER; ++ph) { a.ph_lo = ph; a.ph_hi = ph + 1; void* args[] = {&a};
        hipError_t e = hipLaunchCooperativeKernel((const void*)mk_fwd, dim3(grid), dim3(NWAVES * 64), args, LDS_BYTES, stream);
        if (e != hipSuccess) { fprintf(stderr, "kernel_launch: launch %d failed: %s\n", ph, hipGetErrorString(e)); break; } }
#endif
}
```

```cpp
#include <hip/hip_runtime.h>
#include <hip/hip_cooperative_groups.h>
#include <cstdio>
#include <cstdint>
namespace cg = cooperative_groups;
__device__ __forceinline__ int tid_now() { int t = threadIdx.x; asm volatile("" : "+v"(t)); return t; }
namespace pg8 {
#define PG8_LAS __attribute__((address_space(3)))
typedef unsigned short bf16_t;
typedef short bf16x8 __attribute__((ext_vector_type(8)));
typedef float f32x4 __attribute__((ext_vector_type(4)));
typedef unsigned u32x4 __attribute__((ext_vector_type(4)));
constexpr int BM = 256, BK = 64, HALF = 128, HTB = HALF * BK * 2  , STAGE_BYTES = 8 * HTB, NXCD = 8, WGM = 8;

__host__ __device__ __forceinline__ int lds_byte(int r, int c) { const int st = (r >> 4) * 2 + (c >> 5), rr = r & 15, cc = c & 31, ob = rr * 64 + cc * 2; return st * 1024 + (ob ^ (((ob >> 9) & 1) << 5)); }
__host__ __device__ __forceinline__ void stage_rc(int b, int& R, int& C) { const int st = b / 1024, sb = b % 1024, swz = sb ^ (((sb >> 9) & 1) << 5); R = (st >> 1) * 16 + swz / 64; C = (st & 1) * 32 + (swz % 64) / 2; }
__host__ __device__ __forceinline__ int perm32(int rho) { const int n = rho >> 4, i = rho & 15; return 8 * (i >> 2) + 4 * n + (i & 3); }

struct Unit { int pm, pn; };
struct Gemm { const bf16_t* A; const bf16_t* Bt; int K, lda, ldb; };

struct StaticOrder {
    int nM, nN, nwg, G, c;
    __host__ __device__ void init(int M, int N, int G_, int c_) { nM = M / BM; nN = N / BM; nwg = nM * nN; G = G_; c = c_; }
    __host__ __device__ bool next(int i, Unit& u) const {
        const long L = (long)i * G + c; if (L >= nwg) return false;
        int wgid = (int)L; { const int q = nwg / NXCD, r = nwg % NXCD, xcd = wgid % NXCD, off = wgid / NXCD; wgid = (xcd < r ? xcd * (q + 1) : r * (q + 1) + (xcd - r) * q) + off; }
        const int nig = WGM * nN, gid = wgid / nig, fm = gid * WGM, gsz = (nM - fm) < WGM ? (nM - fm) : WGM;
        u.pm = fm + ((wgid % nig) % gsz); u.pn = (wgid % nig) / gsz; return true;
    }
    __device__ __forceinline__ void a_ready(const Unit&) const {}
    __device__ __forceinline__ void done(const Unit&) const {}
};

__device__ __forceinline__ unsigned cvt_pk_bf16(float lo, float hi) { unsigned r; asm volatile("v_cvt_pk_bf16_f32 %0, %1, %2" : "=v"(r) : "v"(lo), "v"(hi)); return r; }
typedef float f32x2 __attribute__((ext_vector_type(2)));
__device__ __forceinline__ f32x2 gelu_pk(f32x2 v) {
    const f32x2 av = __builtin_elementwise_abs(v), d = av * 0.2316418882f + 1.0f;
    f32x2 t; t.x = __builtin_amdgcn_rcpf(d.x); t.y = __builtin_amdgcn_rcpf(d.y);
    f32x2 q = t * 0.5307027145f + (-0.7265760135f); q = q * t + 0.7107068705f; q = q * t + (-0.142248368f); q = q * t + 0.127414796f; q = q * t;
    const f32x2 s = (v * v) * (-0.72134752044f);
    f32x2 e; e.x = __builtin_amdgcn_exp2f(s.x); e.y = __builtin_amdgcn_exp2f(s.y);
    const f32x2 m = v * (q * e), r = v - m;
    f32x2 o; o.x = v.x < 0.f ? m.x : r.x; o.y = v.y < 0.f ? m.y : r.y; return o;
}

template <int ACT  > struct EpiBf16 {
    static constexpr bool PERM = true, AFTER_DRAIN = false, HAS_MID = false; static_assert(ACT == 0 || ACT == 1, "EpiBf16: ACT is 0 (none) or 1 (gelu_pk)");
    bf16_t* O; int ldc; const float* bias; int split_cols; size_t split_stride; float scale0;
    __device__ __forceinline__ void operator()(const f32x4 (&acc)[2][2][4][2], const Unit& u, int wr, int wc, int fr, int fq) const {
        const int row0 = u.pm * BM + wr * 64 + fr; int colt = u.pn * BM; bf16_t* base = O;
        float sc = 1.f; if (split_cols) { const int t = colt / split_cols; base += (size_t)t * split_stride; colt -= t * split_cols; if (t == 0) sc = scale0; }
        const int col0 = colt + wc * 32 + 8 * fq, bcol0 = u.pn * BM + wc * 32 + 8 * fq;
        f32x4 bv[2][2];
#pragma unroll
        for (int bj = 0; bj < 2; ++bj)
#pragma unroll
            for (int n = 0; n < 2; ++n) bv[bj][n] = bias ? *(const f32x4*)(bias + bcol0 + bj * HALF + 4 * n) : (f32x4){0.f, 0.f, 0.f, 0.f};
#pragma unroll
        for (int ai = 0; ai < 2; ++ai)
#pragma unroll
            for (int m = 0; m < 4; ++m) { bf16_t* rowp = base + (size_t)(row0 + ai * HALF + m * 16) * ldc + col0;
#pragma unroll
                for (int bj = 0; bj < 2; ++bj) { f32x4 v0 = acc[ai][bj][m][0] + bv[bj][0], v1 = acc[ai][bj][m][1] + bv[bj][1];
                    if (ACT == 1) { f32x2 a = gelu_pk((f32x2){v0[0], v0[1]}), b = gelu_pk((f32x2){v0[2], v0[3]}), c = gelu_pk((f32x2){v1[0], v1[1]}), d = gelu_pk((f32x2){v1[2], v1[3]});
                        v0 = (f32x4){a.x, a.y, b.x, b.y}; v1 = (f32x4){c.x, c.y, d.x, d.y}; }
                    v0 = v0 * sc; v1 = v1 * sc; u32x4 w; w.x = cvt_pk_bf16(v0[0], v0[1]); w.y = cvt_pk_bf16(v0[2], v0[3]); w.z = cvt_pk_bf16(v1[0], v1[1]); w.w = cvt_pk_bf16(v1[2], v1[3]);
                    *(u32x4*)(rowp + bj * HALF) = w; } }
    }
};
typedef float f32x2e __attribute__((ext_vector_type(2)));
__device__ __forceinline__ float bf_lo(unsigned w) { return __uint_as_float(w << 16); }
__device__ __forceinline__ float bf_hi(unsigned w) { return __uint_as_float(w & 0xffff0000u); }
__device__ __forceinline__ void unpack8(const u32x4 w, float (&f)[8]) { f[0] = bf_lo(w.x); f[1] = bf_hi(w.x); f[2] = bf_lo(w.y); f[3] = bf_hi(w.y); f[4] = bf_lo(w.z); f[5] = bf_hi(w.z); f[6] = bf_lo(w.w); f[7] = bf_hi(w.w); }
__device__ __forceinline__ u32x4 pack8(const float (&f)[8]) { u32x4 w; w.x = cvt_pk_bf16(f[0], f[1]); w.y = cvt_pk_bf16(f[2], f[3]); w.z = cvt_pk_bf16(f[4], f[5]); w.w = cvt_pk_bf16(f[6], f[7]); return w; }
__device__ __forceinline__ float sigm(float a) { return __builtin_amdgcn_rcpf(1.0f + __builtin_amdgcn_exp2f(-1.4426950408889634f * a)); }
#define PG8_ACC8(f, ai, bj, m) do { const f32x4 _v0 = acc[ai][bj][m][0], _v1 = acc[ai][bj][m][1]; f[0] = _v0[0]; f[1] = _v0[1]; f[2] = _v0[2]; f[3] = _v0[3]; f[4] = _v1[0]; f[5] = _v1[1]; f[6] = _v1[2]; f[7] = _v1[3]; } while (0)

struct EpiWin {
    static constexpr bool PERM = true, AFTER_DRAIN = false, HAS_MID = false;
    bf16_t* proj; bf16_t* ing; float qscale;
    __device__ __forceinline__ void operator()(const f32x4 (&acc)[2][2][4][2], const Unit& u, int wr, int wc, int fr, int fq) const {
        const float sc = (u.pn == 2 || u.pn == 3) ? qscale : 1.0f;
#pragma unroll
        for (int ai = 0; ai < 2; ++ai)
#pragma unroll
            for (int m = 0; m < 4; ++m) { int row = u.pm * BM + ai * HALF + wr * 64 + m * 16 + fr; asm volatile("" : "+v"(row));
#pragma unroll
                for (int bj = 0; bj < 2; ++bj) { const int c0 = u.pn * BM + bj * HALF + wc * 32 + 8 * fq;
                    float f[8]; PG8_ACC8(f, ai, bj, m);
#pragma unroll
                    for (int j = 0; j < 8; ++j) f[j] *= sc;
                    bf16_t* dst;
                    if (u.pn < 2) { const int g = c0 >> 4, hi0 = c0 & 15, b = row >> 12, tok = row & 4095; dst = ing + ((size_t)(g * 2048 + b * 256 + (tok >> 4)) * 384 + (tok & 15) * 16 + hi0); }
                    else dst = proj + (size_t)row * 4096 + c0;
                    *(u32x4*)dst = pack8(f); asm volatile("" ::: "memory"); } }
    }
};
struct EpiS5E {
    static constexpr bool PERM = true, AFTER_DRAIN = true, HAS_MID = false;
    bf16_t* ing; const float* lamT;
    __device__ __forceinline__ void fused(f32x4 (&acc)[2][2][4][2], const Unit& u, int wr, int wc, int fr, int fq, PG8_LAS unsigned char* lds, int wid, int lane) const {
        PG8_LAS float* EL = (PG8_LAS float*)lds;
        PG8_LAS f32x2e* SEG = (PG8_LAS f32x2e*)(lds + 135168);
#pragma unroll
        for (int ai = 0; ai < 2; ++ai)
#pragma unroll
            for (int m = 0; m < 4; ++m) { PG8_LAS float* p = EL + (ai * HALF + wr * 64 + m * 16 + fr) * 132 + wc * 32 + 8 * fq;
                *(PG8_LAS f32x4*)p = acc[ai][0][m][0]; *(PG8_LAS f32x4*)(p + 4) = acc[ai][0][m][1]; }
        asm volatile("s_waitcnt lgkmcnt(0)" ::: "memory"); __builtin_amdgcn_s_barrier(); asm volatile("" ::: "memory");
        const float lr = lamT[2 * lane], li = lamT[2 * lane + 1];
        float xr = 0.f, xi = 0.f;
        for (int c = 32 * wid; c < 32 * wid + 32; ++c) { const f32x2e e = *(PG8_LAS f32x2e*)(EL + c * 132 + 2 * lane); const float nr = lr * xr - li * xi + e.x, ni = lr * xi + li * xr + e.y; xr = nr; xi = ni; }
        SEG[wid * 64 + lane] = (f32x2e){xr, xi};
        asm volatile("s_waitcnt lgkmcnt(0)" ::: "memory"); __builtin_amdgcn_s_barrier(); asm volatile("" ::: "memory");
        float pr = lr, pi = li;
#pragma unroll
        for (int s = 0; s < 5; ++s) { const float nr = pr * pr - pi * pi, ni = 2.f * pr * pi; pr = nr; pi = ni; }
        xr = 0.f; xi = 0.f;
        for (int j = 0; j < wid; ++j) { const f32x2e e = SEG[j * 64 + lane]; const float nr = pr * xr - pi * xi + e.x, ni = pr * xi + pi * xr + e.y; xr = nr; xi = ni; }
        for (int c = 32 * wid; c < 32 * wid + 32; ++c) {
            *(unsigned*)(ing + (size_t)(u.pm * BM + c) * 384 + 256 + 2 * lane) = cvt_pk_bf16(xr, xi);
            const f32x2e e = *(PG8_LAS f32x2e*)(EL + c * 132 + 2 * lane); const float nr = lr * xr - li * xi + e.x, ni = lr * xi + li * xr + e.y; xr = nr; xi = ni; }
        asm volatile("s_waitcnt vmcnt(0) lgkmcnt(0)" ::: "memory"); __threadfence(); __builtin_amdgcn_s_barrier(); asm volatile("" ::: "memory");
    }
};
struct EpiS5Main {
    static constexpr bool PERM = true, AFTER_DRAIN = false, HAS_MID = false;
    const bf16_t* ing; const float* dskip; bf16_t* z;
    __device__ __forceinline__ void operator()(const f32x4 (&acc)[2][2][4][2], const Unit& u, int wr, int wc, int fr, int fq) const {
        const int g = u.pn, b = u.pm & 7;
#pragma unroll
        for (int bj = 0; bj < 2; ++bj) { const int c0 = bj * HALF + wc * 32 + 8 * fq, t = c0 >> 4, ho0 = c0 & 15;
            const f32x4 d0 = *(const f32x4*)(dskip + g * 16 + ho0), d1 = *(const f32x4*)(dskip + g * 16 + ho0 + 4);
            const float dk[8] = {d0[0], d0[1], d0[2], d0[3], d1[0], d1[1], d1[2], d1[3]};
#pragma unroll
            for (int ai = 0; ai < 2; ++ai)
#pragma unroll
                for (int m = 0; m < 4; ++m) { int c = ai * HALF + wr * 64 + m * 16 + fr; asm volatile("" : "+v"(c));
                    float f[8], uu[8]; PG8_ACC8(f, ai, bj, m); unpack8(*(const u32x4*)(ing + (size_t)(u.pm * BM + c) * 384 + c0), uu);
#pragma unroll
                    for (int j = 0; j < 8; ++j) { const float y = f[j] + dk[j] * uu[j]; f[j] = y * sigm(1.5957691216057308f * (y + 0.044715f * y * y * y)); }
                    *(u32x4*)(z + (size_t)(b * 4096 + c * 16 + t) * 512 + g * 16 + ho0) = pack8(f); asm volatile("" ::: "memory"); } }
    }
};
struct EpiGlu {
    static constexpr bool PERM = true, AFTER_DRAIN = false, HAS_MID = false;
    const bf16_t* z; const float* bglu; bf16_t* proj;
    __device__ __forceinline__ void operator()(const f32x4 (&acc)[2][2][4][2], const Unit& u, int wr, int wc, int fr, int fq) const {
#pragma unroll
        for (int bj = 0; bj < 2; ++bj) { const int c0 = u.pn * BM + bj * HALF + wc * 32 + 8 * fq;
            const f32x4 b0 = *(const f32x4*)(bglu + c0), b1 = *(const f32x4*)(bglu + c0 + 4);
            const float bb[8] = {b0[0], b0[1], b0[2], b0[3], b1[0], b1[1], b1[2], b1[3]};
#pragma unroll
            for (int ai = 0; ai < 2; ++ai)
#pragma unroll
                for (int m = 0; m < 4; ++m) { int row = u.pm * BM + ai * HALF + wr * 64 + m * 16 + fr; asm volatile("" : "+v"(row));
                    float f[8], zz[8]; PG8_ACC8(f, ai, bj, m); unpack8(*(const u32x4*)(z + (size_t)row * 512 + c0), zz);
#pragma unroll
                    for (int j = 0; j < 8; ++j) f[j] = zz[j] * sigm(f[j] + bb[j]);
                    *(u32x4*)(proj + (size_t)row * 4096 + c0) = pack8(f); asm volatile("" ::: "memory"); } }
    }
};
struct EpiMerge {
    static constexpr bool PERM = true, AFTER_DRAIN = false, HAS_MID = true;
    const bf16_t* proj; bf16_t* mg; int mid_t;
    __device__ __forceinline__ void mid(f32x4 (&acc)[2][2][4][2], const Unit& u, int wr, int wc, int fr, int fq) const {
#pragma unroll
        for (int ai = 0; ai < 2; ++ai)
#pragma unroll
            for (int m = 0; m < 4; ++m) { int row = u.pm * BM + ai * HALF + wr * 64 + m * 16 + fr; asm volatile("" : "+v"(row));
#pragma unroll
                for (int bj = 0; bj < 2; ++bj) { const int c0 = u.pn * BM + bj * HALF + wc * 32 + 8 * fq;
                    float ga[8], gb[8]; unpack8(*(const u32x4*)(proj + (size_t)row * 4096 + 2048 + c0), ga); unpack8(*(const u32x4*)(proj + (size_t)row * 4096 + 3072 + c0), gb);
                    float r[8];
#pragma unroll
                    for (int j = 0; j < 8; ++j) r[j] = (1.0f + __builtin_amdgcn_exp2f(-1.4426950408889634f * gb[j])) * __builtin_amdgcn_rcpf(1.0f + __builtin_amdgcn_exp2f(-1.4426950408889634f * ga[j]));
                    acc[ai][bj][m][0] *= (f32x4){r[0], r[1], r[2], r[3]}; acc[ai][bj][m][1] *= (f32x4){r[4], r[5], r[6], r[7]};
                    asm volatile("" : "+v"(acc[ai][bj][m][0]), "+v"(acc[ai][bj][m][1]) :: "memory"); } }
    }
    __device__ __forceinline__ void operator()(const f32x4 (&acc)[2][2][4][2], const Unit& u, int wr, int wc, int fr, int fq) const {
#pragma unroll
        for (int ai = 0; ai < 2; ++ai)
#pragma unroll
            for (int m = 0; m < 4; ++m) { int row = u.pm * BM + ai * HALF + wr * 64 + m * 16 + fr; asm volatile("" : "+v"(row));
#pragma unroll
                for (int bj = 0; bj < 2; ++bj) { const int c0 = u.pn * BM + bj * HALF + wc * 32 + 8 * fq;
                    float f[8], gb[8]; PG8_ACC8(f, ai, bj, m); unpack8(*(const u32x4*)(proj + (size_t)row * 4096 + 3072 + c0), gb);
#pragma unroll
                    for (int j = 0; j < 8; ++j) f[j] *= sigm(gb[j]);
                    *(u32x4*)(mg + (size_t)row * 1024 + c0) = pack8(f); asm volatile("" ::: "memory"); } }
    }
};
struct EpiSwiglu {
    static constexpr bool PERM = true, AFTER_DRAIN = false, HAS_MID = false;
    bf16_t* hh;
    __device__ __forceinline__ void operator()(const f32x4 (&acc)[2][2][4][2], const Unit& u, int wr, int wc, int fr, int fq) const {
#pragma unroll
        for (int ai = 0; ai < 2; ++ai)
#pragma unroll
            for (int m = 0; m < 4; ++m) { int row = u.pm * BM + ai * HALF + wr * 64 + m * 16 + fr; asm volatile("" : "+v"(row));
                float gt[8], up[8]; PG8_ACC8(gt, ai, 0, m); PG8_ACC8(up, ai, 1, m);
#pragma unroll
                for (int j = 0; j < 8; ++j) gt[j] = gt[j] * sigm(gt[j]) * up[j];
                *(u32x4*)(hh + (size_t)row * 2816 + u.pn * HALF + wc * 32 + 8 * fq) = pack8(gt); }
    }
};
struct OneUnit { int pm, pn;
    __device__ __forceinline__ bool next(int i, Unit& u) const { if (i) return false; u.pm = pm; u.pn = pn; return true; }
    __device__ __forceinline__ void a_ready(const Unit&) const {}
    __device__ __forceinline__ void done(const Unit&) const {} };
template <class Epi, class Sched, bool ALIGN_EPI = false, bool SP2 = false>
__device__ __forceinline__ void gemm_phase(PG8_LAS unsigned char* lds, const Gemm g, const Sched& S, const Epi& E) {
    const int tid = tid_now(), wid = __builtin_amdgcn_readfirstlane(tid >> 6), lane = tid & 63, wr = wid >> 2, wc = wid & 3, fr = lane & 15, fq = lane >> 4;
    int K = g.K; asm volatile("" : "+s"(K)); const int nt = K / BK;
    unsigned voffA[2], voffB[2];
#pragma unroll
    for (int i = 0; i < 2; ++i) { int R, C; stage_rc(tid * 16 + i * 8192, R, C); const int Rb = Epi::PERM ? ((R & ~31) + perm32(R & 31)) : R;
        voffA[i] = (unsigned)(R * g.lda + C) * 2u; voffB[i] = (unsigned)(Rb * g.ldb + C) * 2u; }
    const size_t kstep = (size_t)(BK * 2);
    const unsigned hsA = (unsigned)HALF * g.lda * 2u, hsB = (unsigned)HALF * g.ldb * 2u;
    const unsigned tsA = 2u * hsA, tsB = 2u * hsB;
    const unsigned ldsw = (unsigned)wid * 1024u;
    const int aoff = lds_byte(wr * 64 + fr, fq * 8), boff = lds_byte(wc * 32 + fr, fq * 8);
#define PG8_SA(b, h) (((b) * 2 + (h)) * HTB)
#define PG8_SB(b, h) ((4 + (b) * 2 + (h)) * HTB)
#define PG8_STAGE(bufoff, gbase, voff) do { _Pragma("unroll") for (int _i = 0; _i < 2; ++_i) \
        __builtin_amdgcn_global_load_lds((const unsigned*)((const char*)(gbase) + (voff)[_i]), (PG8_LAS unsigned*)(lds + (bufoff) + ldsw + _i * 8192), 16, 0, 0); } while (0)
#define PG8_LDA(dst, b, h) do { _Pragma("unroll") for (int m = 0; m < 4; ++m) _Pragma("unroll") for (int k = 0; k < 2; ++k) dst[m][k] = *(const PG8_LAS bf16x8*)(lds + PG8_SA(b, h) + aoff + m * 2048 + k * 1024); } while (0)
#define PG8_LDB(dst, b, h) do { _Pragma("unroll") for (int n = 0; n < 2; ++n) _Pragma("unroll") for (int k = 0; k < 2; ++k) dst[n][k] = *(const PG8_LAS bf16x8*)(lds + PG8_SB(b, h) + boff + n * 2048 + k * 1024); } while (0)
#define PG8_MMA(ai, bj, At, Bt) do { __builtin_amdgcn_s_setprio(1); _Pragma("unroll") for (int m = 0; m < 4; ++m) _Pragma("unroll") for (int n = 0; n < 2; ++n) _Pragma("unroll") for (int k = 0; k < 2; ++k) \
        acc[ai][bj][m][n] = __builtin_amdgcn_mfma_f32_16x16x32_bf16(Bt[n][k], At[m][k], acc[ai][bj][m][n], 0, 0, 0); __builtin_amdgcn_s_setprio(0); } while (0)
#define PG8_WAIT_V(n) asm volatile("s_waitcnt vmcnt(" #n ")" ::: "memory")
#define PG8_WAIT_L(n) asm volatile("s_waitcnt lgkmcnt(" #n ")" ::: "memory")
#define PG8_BAR __builtin_amdgcn_s_barrier()
#define PG8_SCHED __builtin_amdgcn_sched_barrier(0)
    Unit cur, nxt; int ui = 0;
    if (!S.next(0, cur)) return;
    f32x4 acc[2][2][4][2];
#pragma unroll
    for (int a = 0; a < 2; ++a)
#pragma unroll
        for (int b = 0; b < 2; ++b)
#pragma unroll
            for (int m = 0; m < 4; ++m)
#pragma unroll
                for (int n = 0; n < 2; ++n) acc[a][b][m][n] = (f32x4){0.f, 0.f, 0.f, 0.f};
    bf16x8 At[4][2], B0[2][2], B1[2][2];
    const char* cA = (const char*)g.A + (size_t)cur.pm * tsA; const char* cB = (const char*)g.Bt + (size_t)cur.pn * tsB;
    S.a_ready(cur);
    if constexpr (SP2) {
        PG8_STAGE(PG8_SB(0, 0), cB, voffB); PG8_STAGE(PG8_SB(0, 1), cB + hsB, voffB); PG8_STAGE(PG8_SA(0, 0), cA, voffA); PG8_STAGE(PG8_SA(0, 1), cA + hsA, voffA);
        if (wr == 1) PG8_BAR;
        PG8_WAIT_V(2); PG8_BAR;
        PG8_STAGE(PG8_SB(1, 0), cB + kstep, voffB); PG8_STAGE(PG8_SA(1, 0), cA + kstep, voffA); PG8_STAGE(PG8_SB(1, 1), cB + hsB + kstep, voffB);
        PG8_WAIT_V(6); PG8_BAR;
    } else {
        PG8_STAGE(PG8_SB(0, 0), cB, voffB); PG8_STAGE(PG8_SA(0, 0), cA, voffA); PG8_STAGE(PG8_SB(0, 1), cB + hsB, voffB); PG8_STAGE(PG8_SA(0, 1), cA + hsA, voffA);
        if (wr == 1) PG8_BAR;
        PG8_WAIT_V(4); PG8_BAR;
        PG8_STAGE(PG8_SB(1, 0), cB + kstep, voffB); PG8_STAGE(PG8_SA(1, 0), cA + kstep, voffA); PG8_STAGE(PG8_SB(1, 1), cB + hsB + kstep, voffB);
        PG8_WAIT_V(6); PG8_BAR;
    }
    for (;;) {
        const bool has_next = S.next(ui + 1, nxt);
        const char* nA = has_next ? (const char*)g.A + (size_t)nxt.pm * tsA : cA; const char* nB = has_next ? (const char*)g.Bt + (size_t)nxt.pn * tsB : cB;
        for (int t = 0; t < nt; t += 2) {
            if constexpr (Epi::HAS_MID) { if (t == E.mid_t) { const int l2 = tid_now() & 63; E.mid(acc, cur, wr, wc, l2 & 15, l2 >> 4); } }
            const bool last = (t == nt - 2);
            const char* a1 = cA + (size_t)(t + 1) * kstep;
            const char* a2 = last ? nA : cA + (size_t)(t + 2) * kstep; const char* b2 = last ? nB : cB + (size_t)(t + 2) * kstep;
            const char* a3 = a2 + kstep; const char* b3 = b2 + kstep;
            if (last && has_next) S.a_ready(nxt);
            if constexpr (SP2) {
            PG8_LDB(B0, 0, 0); PG8_LDB(B1, 0, 1); PG8_SCHED; PG8_LDA(At, 0, 0); PG8_STAGE(PG8_SA(1, 1), a1 + hsA, voffA);
            PG8_WAIT_V(8); PG8_WAIT_L(0); PG8_BAR; PG8_MMA(0, 0, At, B0); PG8_MMA(0, 1, At, B1); PG8_BAR; PG8_SCHED;
            PG8_LDA(At, 0, 1); PG8_STAGE(PG8_SB(0, 0), b2, voffB); PG8_STAGE(PG8_SB(0, 1), b2 + hsB, voffB); PG8_STAGE(PG8_SA(0, 0), a2, voffA);
            PG8_WAIT_V(8); PG8_WAIT_L(0); PG8_BAR; PG8_MMA(1, 0, At, B0); PG8_MMA(1, 1, At, B1); PG8_BAR; PG8_SCHED;
            PG8_LDB(B0, 1, 0); PG8_LDB(B1, 1, 1); PG8_SCHED; PG8_LDA(At, 1, 0); PG8_STAGE(PG8_SA(0, 1), a2 + hsA, voffA);
            PG8_WAIT_V(8); PG8_WAIT_L(0); PG8_BAR; PG8_MMA(0, 0, At, B0); PG8_MMA(0, 1, At, B1); PG8_BAR; PG8_SCHED;
            PG8_LDA(At, 1, 1); PG8_STAGE(PG8_SB(1, 0), b3, voffB); PG8_STAGE(PG8_SB(1, 1), b3 + hsB, voffB); PG8_STAGE(PG8_SA(1, 0), a3, voffA);
            PG8_WAIT_V(8); PG8_WAIT_L(0); PG8_BAR; PG8_MMA(1, 0, At, B0); PG8_MMA(1, 1, At, B1); PG8_BAR; PG8_SCHED;
            } else {
            PG8_LDB(B0, 0, 0); PG8_SCHED; PG8_LDA(At, 0, 0); PG8_STAGE(PG8_SA(1, 1), a1 + hsA, voffA);
            PG8_WAIT_L(8); PG8_BAR; PG8_WAIT_L(0); PG8_MMA(0, 0, At, B0); PG8_BAR; PG8_SCHED;
            PG8_LDB(B1, 0, 1); PG8_STAGE(PG8_SB(0, 0), b2, voffB);
            PG8_BAR; PG8_WAIT_L(0); PG8_MMA(0, 1, At, B1); PG8_BAR;
            PG8_LDA(At, 0, 1); PG8_STAGE(PG8_SA(0, 0), a2, voffA);
            PG8_BAR; PG8_WAIT_L(0); PG8_MMA(1, 0, At, B0); PG8_BAR; PG8_SCHED;
            PG8_STAGE(PG8_SB(0, 1), b2 + hsB, voffB);
            PG8_WAIT_V(6); PG8_BAR; PG8_MMA(1, 1, At, B1); PG8_BAR;
            PG8_LDB(B0, 1, 0); PG8_SCHED; PG8_LDA(At, 1, 0); PG8_STAGE(PG8_SA(0, 1), a2 + hsA, voffA);
            PG8_WAIT_L(8); PG8_BAR; PG8_WAIT_L(0); PG8_MMA(0, 0, At, B0); PG8_BAR; PG8_SCHED;
            PG8_LDB(B1, 1, 1); PG8_STAGE(PG8_SB(1, 0), b3, voffB);
            PG8_BAR; PG8_WAIT_L(0); PG8_MMA(0, 1, At, B1); PG8_BAR;
            PG8_LDA(At, 1, 1); PG8_STAGE(PG8_SA(1, 0), a3, voffA);
            PG8_BAR; PG8_WAIT_L(0); PG8_MMA(1, 0, At, B0); PG8_BAR; PG8_SCHED;
            PG8_STAGE(PG8_SB(1, 1), b3 + hsB, voffB);
            PG8_WAIT_V(6); PG8_BAR; PG8_MMA(1, 1, At, B1); PG8_BAR;
            }
        }
        if constexpr (ALIGN_EPI) { if (wr == 0) PG8_BAR; }
        if constexpr (!Epi::AFTER_DRAIN) { const int l2 = tid_now() & 63; E(acc, cur, wr, wc, l2 & 15, l2 >> 4); S.done(cur); }
        if (!has_next) break;
#pragma unroll
        for (int a = 0; a < 2; ++a)
#pragma unroll
            for (int b = 0; b < 2; ++b)
#pragma unroll
                for (int m = 0; m < 4; ++m)
#pragma unroll
                    for (int n = 0; n < 2; ++n) acc[a][b][m][n] = (f32x4){0.f, 0.f, 0.f, 0.f};
        cur = nxt; cA = nA; cB = nB; ++ui;
        if constexpr (ALIGN_EPI) { if (wr == 1) PG8_BAR; }
    }
    PG8_WAIT_V(0);
    if constexpr (!ALIGN_EPI) { if (wr == 0) PG8_BAR; }
    PG8_BAR;
    if constexpr (Epi::AFTER_DRAIN) { const int l2 = tid_now() & 63; E.fused(acc, cur, wr, wc, l2 & 15, l2 >> 4, lds, wid, l2); S.done(cur); }
#undef PG8_SA
#undef PG8_SB
#undef PG8_STAGE
#undef PG8_LDA
#undef PG8_LDB
#undef PG8_MMA
#undef PG8_WAIT_V
#undef PG8_WAIT_L
#undef PG8_BAR
#undef PG8_SCHED
}
}
#include <hip/hip_bf16.h>
#include <cmath>
namespace attn_body {
using bf16=__hip_bfloat16;
using bf16x8=__attribute__((ext_vector_type(8)))short;
using s16x4=__attribute__((ext_vector_type(4)))short;
using f32x16=__attribute__((ext_vector_type(16)))float;
using u32x4=__attribute__((ext_vector_type(4)))unsigned;
constexpr int BATCH=8,NHEAD=8,SEQ=4096,D=64,DM=4096;
constexpr int NW=8,QBLK=32,QB=QBLK*NW,KVBLK=64,NQB=SEQ/QB;
constexpr int ATTN_PITCH=DM, ATTN_UNIT_ROWS=QB;
__device__ __forceinline__ int crow(int r,int hi){return (r&3)+8*(r>>2)+4*hi;}
#define SBAR() __builtin_amdgcn_sched_barrier(0)
__device__ __forceinline__ void cmask(f32x16&p0,f32x16&p1,int jb,int qrel,int hi){
  const float NEG=-INFINITY; int kb=64*jb+4*hi;
  #pragma unroll
  for(int r=0;r<16;++r){int kv=kb+(r&3)+8*(r>>2); if(kv>qrel)p0[r]=NEG; if(kv+32>qrel)p1[r]=NEG;}
}

constexpr int NSLOT=3, SLOTB=10240;
constexpr int LDS_K=0, LDS_V=NSLOT*SLOTB, LDS_WS=2*NSLOT*SLOTB, LDS_OST=LDS_WS+NW*64*4, LDS_BYTES=LDS_OST+NW*4096;
constexpr float C2=0.125f*1.4426950408889634f;
__device__ __forceinline__ void glds16(const void*gsrc,unsigned lds_dst){unsigned keep;
  asm volatile("s_mov_b32 %0, m0\n\ts_mov_b32 m0, %2\n\ts_nop 0\n\tglobal_load_lds_dwordx4 %1, off\n\ts_mov_b32 m0, %0":"=&s"(keep):"v"(gsrc),"s"(lds_dst):"memory");}
__device__ __forceinline__ float max3f(float a,float b,float c){float r;asm("v_max3_f32 %0, %1, %2, %3":"=v"(r):"v"(a),"v"(b),"v"(c));return r;}
__device__ __forceinline__ float max2f(float a,float b){float r;asm("v_max_f32_e32 %0, %1, %2":"=v"(r):"v"(a),"v"(b));return r;}
__device__ __forceinline__ float fadd_s(float a,float b){float r;asm("v_add_f32_e32 %0, %1, %2":"=v"(r):"v"(a),"v"(b));return r;}
__device__ __forceinline__ float fsub_s(float a,float b){float r;asm("v_sub_f32_e32 %0, %1, %2":"=v"(r):"v"(a),"v"(b));return r;}
typedef float f32x2_t __attribute__((ext_vector_type(2))); typedef __bf16 bf16x2_t __attribute__((ext_vector_type(2)));
__device__ __forceinline__ unsigned cvtpk_s(float lo,float hi){f32x2_t v={lo,hi};bf16x2_t b=__builtin_convertvector(v,bf16x2_t);return __builtin_bit_cast(unsigned,b);}
#define WAIT_BAR(N) asm volatile("s_waitcnt vmcnt(" #N ") lgkmcnt(0)\n\ts_barrier":::"memory")

#define MFX(a,b,c) __builtin_amdgcn_mfma_f32_32x32x8bf16_1k(a,b,c,0,0,0)
__device__ __forceinline__ void qkt(f32x16&p0,f32x16&p1,const char*Kslot,const bf16x8*qr,const s16x4 qx,const f32x16&negm,int r32,int hi){
  const char*kb=Kslot+hi*1024+r32*16;
  #pragma unroll
  for(int d0=0;d0<4;++d0){
    const bf16x8 b0=*reinterpret_cast<const bf16x8*>(kb+d0*2048);
    const bf16x8 b1=*reinterpret_cast<const bf16x8*>(kb+d0*2048+512);
    if(d0==0){p0=__builtin_amdgcn_mfma_f32_32x32x16_bf16(b0,qr[0],negm,0,0,0);p1=__builtin_amdgcn_mfma_f32_32x32x16_bf16(b1,qr[0],negm,0,0,0);}
    else{p0=__builtin_amdgcn_mfma_f32_32x32x16_bf16(b0,qr[d0],p0,0,0,0);p1=__builtin_amdgcn_mfma_f32_32x32x16_bf16(b1,qr[d0],p1,0,0,0);}}
  { const s16x4 x0=*reinterpret_cast<const s16x4*>(kb+8192), x1=*reinterpret_cast<const s16x4*>(kb+8192+512); p0=MFX(x0,qx,p0); p1=MFX(x1,qx,p1); }
}
typedef __attribute__((address_space(3))) const char* lds_cptr;
typedef short v4i16_t __attribute__((ext_vector_type(4)));
__device__ __forceinline__ void kload8(bf16x8*kf,lds_cptr kp){
  kf[0]=*(const __attribute__((address_space(3))) bf16x8*)(kp);      kf[1]=*(const __attribute__((address_space(3))) bf16x8*)(kp+512);
  kf[2]=*(const __attribute__((address_space(3))) bf16x8*)(kp+2048); kf[3]=*(const __attribute__((address_space(3))) bf16x8*)(kp+2560);
  kf[4]=*(const __attribute__((address_space(3))) bf16x8*)(kp+4096); kf[5]=*(const __attribute__((address_space(3))) bf16x8*)(kp+4608);
  kf[6]=*(const __attribute__((address_space(3))) bf16x8*)(kp+6144); kf[7]=*(const __attribute__((address_space(3))) bf16x8*)(kp+6656);
}
__device__ __forceinline__ void kloadx(s16x4*kx,lds_cptr kp){ kx[0]=*(const __attribute__((address_space(3))) s16x4*)(kp+8192); kx[1]=*(const __attribute__((address_space(3))) s16x4*)(kp+8192+512); }
__device__ __forceinline__ void kload2(bf16x8*kf,lds_cptr kp,int j){ kf[2*j]=*(const __attribute__((address_space(3))) bf16x8*)(kp+j*2048); kf[2*j+1]=*(const __attribute__((address_space(3))) bf16x8*)(kp+j*2048+512); }
__device__ __forceinline__ s16x4 vtr(lds_cptr p){ return __builtin_bit_cast(s16x4,__builtin_amdgcn_ds_read_tr16_b64_v4i16((__attribute__((address_space(3))) v4i16_t*)p)); }
__device__ __forceinline__ float rowmax(const f32x16&p0,const f32x16&p1){
  float a=max3f(p0[0],p0[1],p1[0]),b=max3f(p0[2],p0[3],p1[1]);a=max3f(a,p1[2],p1[3]);
  #pragma unroll
  for(int r=4;r<16;r+=4){a=max3f(a,p0[r],p0[r+1]);b=max3f(b,p0[r+2],p0[r+3]);a=max3f(a,p1[r],p1[r+1]);b=max3f(b,p1[r+2],p1[r+3]);}
  const float m=max2f(a,b);
  auto rr=__builtin_amdgcn_permlane32_swap(__float_as_uint(m),__float_as_uint(m),false,false);
  return max2f(__uint_as_float(rr[0]),__uint_as_float(rr[1]));
}
__device__ __forceinline__ void pv(f32x16*o,int vb,bf16x8 pa0,bf16x8 pa1,bf16x8 pa2,bf16x8 pa3){
  #pragma unroll
  for(int d0=0;d0<2;++d0){s16x4 lo[4],hi[4];
    #pragma unroll
    for(int ks=0;ks<4;++ks){
      asm volatile("ds_read_b64_tr_b16 %0,%1 offset:%c2":"=&v"(lo[ks]):"v"(vb),"i"(d0*4096+ks*1024):"memory");
      asm volatile("ds_read_b64_tr_b16 %0,%1 offset:%c2":"=&v"(hi[ks]):"v"(vb),"i"(d0*4096+ks*1024+512):"memory");}
    asm volatile("s_waitcnt lgkmcnt(0)":::"memory");SBAR();
    #define PK(k) (bf16x8){lo[k][0],lo[k][1],lo[k][2],lo[k][3],hi[k][0],hi[k][1],hi[k][2],hi[k][3]}
    o[d0]=__builtin_amdgcn_mfma_f32_32x32x16_bf16(pa0,PK(0),o[d0],0,0,0);
    o[d0]=__builtin_amdgcn_mfma_f32_32x32x16_bf16(pa1,PK(1),o[d0],0,0,0);
    o[d0]=__builtin_amdgcn_mfma_f32_32x32x16_bf16(pa2,PK(2),o[d0],0,0,0);
    o[d0]=__builtin_amdgcn_mfma_f32_32x32x16_bf16(pa3,PK(3),o[d0],0,0,0);
    #undef PK
  }
}

#ifndef ATTN_STORE16
#define ATTN_STORE16(p,v) (*(u32x4*)(p)=(v))
#endif
template<int THRL> __device__ __forceinline__ void attn_unit(int b,int h,int qb,const bf16*Q,const bf16*__restrict__ K,const bf16*__restrict__ V,bf16*O,const float*__restrict__ CQ,const bf16*__restrict__ KX,char*shm){
  const int tid=tid_now(),lane=tid&63,r32=lane&31,hi=lane>>5; const int wid=__builtin_amdgcn_readfirstlane(tid>>6);
  const long rowbase=(long)b*SEQ; const int q0=qb*QB;
  const bf16*Qw=Q+(rowbase+q0+wid*QBLK)*DM+h*D;
  const bf16*Kh=K+rowbase*DM+h*D,*Vh=V+rowbase*DM+h*D;
  const unsigned lds0=(unsigned)(uintptr_t)shm;
  float*wsf=(float*)(shm+LDS_WS)+wid*64;
  const bf16*ksrc=Kh+(long)lane*DM+wid*8;
  const bf16*kxsrc=KX+((long)(b*NHEAD+h)*SEQ+lane)*8;
  const float cqv=CQ[(long)(b*NHEAD+h)*SEQ+q0+wid*QBLK+r32];
  const bf16*vsrc=Vh+(long)(16*(wid&3)+(lane>>2))*DM+(wid>>2)*32+(lane&3)*8;
  const unsigned kdst=lds0+LDS_K+wid*1024, vdst=lds0+LDS_V+wid*1024;
  #define DMA_K(t,slot) do{ glds16(ksrc+(long)(t)*KVBLK*DM,(unsigned)__builtin_amdgcn_readfirstlane(kdst+(slot))); glds16(kxsrc+(long)(t)*KVBLK*8,(unsigned)__builtin_amdgcn_readfirstlane(lds0+LDS_K+8192+(slot))); }while(0)
  #define DMA_V(t,slot) glds16(vsrc+(long)(t)*KVBLK*DM,(unsigned)__builtin_amdgcn_readfirstlane(vdst+(slot)))
  const int vb0=(int)(lds0+LDS_V)+((lane>>4)&1)*32+(lane&3)*8+(4*hi+((lane&15)>>2))*64;
  const char*Kbase=shm+LDS_K; bf16x8 kf[8]; s16x4 kx[2];
  const lds_cptr shm3=(lds_cptr)shm; const lds_cptr kp0=shm3+LDS_K+hi*1024+r32*16; const lds_cptr vp0=shm3+LDS_V+((lane>>4)&1)*32+(lane&3)*8+(4*hi+((lane&15)>>2))*64;
  const int NT=(q0+QB)/KVBLK;
  DMA_K(0,0);DMA_V(0,0);DMA_K(1,SLOTB);
  bf16x8 qr[4];
  s16x4 qx; { const uint2 one3=make_uint2(0x3F803F80u,0x00003F80u); qx=__builtin_bit_cast(s16x4,one3); }
  #pragma unroll
  for(int d0=0;d0<4;++d0)qr[d0]=*reinterpret_cast<const bf16x8*>(&Qw[(long)r32*DM+d0*16+hi*8]);
  float l_reg=0.f;f32x16 o[2];o[0]=f32x16{};o[1]=f32x16{};f32x16 negm;
  _Pragma("unroll") for(int r=0;r<16;++r)negm[r]=cqv; asm volatile("":"+v"(negm));
  const int qrel=wid*QBLK+r32;
  #define CMASK(P0,P1,t) do{int jb_=(t)-(NT-4); if(jb_>=0)cmask(P0,P1,jb_,qrel,hi);}while(0)
  bool resc=false;
  #define START(P0,P1) do{ const float rm=rowmax(P0,P1); resc=false; \
    { const float dl=rm; \
      _Pragma("unroll") for(int r=0;r<16;++r){P0[r]=fsub_s(P0[r],dl);P1[r]=fsub_s(P1[r],dl);} \
      _Pragma("unroll") for(int r=0;r<16;++r)negm[r]=fsub_s(negm[r],dl); asm volatile("":"+v"(negm)); } \
    _Pragma("unroll") for(int r=0;r<16;++r)P0[r]=__builtin_amdgcn_exp2f(P0[r]); }while(0)
  #define RESC() do{ if(resc){ asm volatile("s_waitcnt lgkmcnt(0)":::"memory"); \
      _Pragma("unroll") for(int d_=0;d_<2;++d_) _Pragma("unroll") for(int r=0;r<16;++r)o[d_][r]*=wsf[crow(r,hi)]; } }while(0)
  f32x16 pA0,pA1,pB0,pB1;
  int sl_prev=0,sl_cur=0,sl_next=SLOTB;
  #define ROT() do{sl_prev=sl_cur;sl_cur=sl_next;sl_next=(sl_next==(NSLOT-1)*SLOTB)?0:sl_next+SLOTB;}while(0)
  DMA_K(2,2*SLOTB);
  WAIT_BAR(5);
  qkt(pA0,pA1,Kbase,qr,qx,negm,r32,hi);asm volatile("s_nop 15\n\ts_nop 7":"+v"(pA0),"+v"(pA1));CMASK(pA0,pA1,0);
  START(pA0,pA1);
  _Pragma("unroll") for(int r=0;r<16;++r)pA1[r]=__builtin_amdgcn_exp2f(pA1[r]);
  WAIT_BAR(0);
  DMA_K(3,0);DMA_V(1,SLOTB);
  ROT();
  kload8(kf,kp0+sl_cur); kloadx(kx,kp0+sl_cur);
  WAIT_BAR(3);
  s16x4 vlo[8],vhi[8]; u32x4 pw0,pw1,pw2,pw3;
  #define PKW(P,B) cvtpk_s(P[B],P[B+1])
  #define PAF(k) __builtin_bit_cast(bf16x8,pw##k)
  #define VFR(i) (bf16x8){vlo[i][0],vlo[i][1],vlo[i][2],vlo[i][3],vhi[i][0],vhi[i][1],vhi[i][2],vhi[i][3]}
  #define PIN(x) asm volatile("":"+v"(x))
  #define MX3(a,b,c) __builtin_fmaxf(__builtin_fmaxf((a),(b)),(c))
  #define GAPA(MF,A0,A1,A2,A3,W0,W1,PW) do{ MF; sacc+=A0; sacc+=A1; sacc+=A2; sacc+=A3; PIN(sacc); W0; W1; PIN(PW); SBAR(); }while(0)
  #define EX(v) __builtin_amdgcn_exp2f(v)
  #define GAPB(MF,X,B) do{ MF; X[B]=EX(X[B]); X[B+1]=EX(X[B+1]); X[B+2]=EX(X[B+2]); X[B+3]=EX(X[B+3]); PIN(X); SBAR(); }while(0)
  #define VRD(i) do{ vlo[i]=vtr(vp_+(((i)>>2)*4096+((i)&3)*1024)); vhi[i]=vtr(vp_+(((i)>>2)*4096+((i)&3)*1024+512)); }while(0)
  #define KRD(G,j) do{ if(G){ kload2(kf,kp0+sl_next,j); SBAR(); } }while(0)
  #define STEP(C0,C1,P0,P1,t,GK,GV,GL) do{ SBAR(); \
    const lds_cptr vp_=vp0+sl_prev; \
    C0=MFX(kx[0],qx,negm); C1=MFX(kx[1],qx,negm); SBAR(); \
    VRD(0); SBAR(); float sacc=(P0[0]+P0[1]); \
    GAPA(C0=__builtin_amdgcn_mfma_f32_32x32x16_bf16(kf[0],qr[0],C0,0,0,0), P0[2],P0[3],P0[4],P0[5],     pw0[0]=PKW(P0,0), pw0[1]=PKW(P0,2), pw0); \
    VRD(4); SBAR(); GAPA(C1=__builtin_amdgcn_mfma_f32_32x32x16_bf16(kf[1],qr[0],C1,0,0,0), P0[6],P0[7],P0[8],P0[9],     pw0[2]=PKW(P0,4), pw0[3]=PKW(P0,6), pw0); \
    VRD(1); SBAR(); GAPA(C0=__builtin_amdgcn_mfma_f32_32x32x16_bf16(kf[2],qr[1],C0,0,0,0),   P0[10],P0[11],P0[12],P0[13], pw1[0]=PKW(P0,8), pw1[1]=PKW(P0,10), pw1); \
    VRD(5); SBAR(); GAPA(C1=__builtin_amdgcn_mfma_f32_32x32x16_bf16(kf[3],qr[1],C1,0,0,0),   P0[14],P0[15],P1[0],P1[1],   pw1[2]=PKW(P0,12),pw1[3]=PKW(P0,14), pw1); \
    VRD(2); SBAR(); GAPA(C0=__builtin_amdgcn_mfma_f32_32x32x16_bf16(kf[4],qr[2],C0,0,0,0),   P1[2],P1[3],P1[4],P1[5],     pw2[0]=PKW(P1,0), pw2[1]=PKW(P1,2), pw2); \
    VRD(6); SBAR(); GAPA(C1=__builtin_amdgcn_mfma_f32_32x32x16_bf16(kf[5],qr[2],C1,0,0,0),   P1[6],P1[7],P1[8],P1[9],     pw2[2]=PKW(P1,4), pw2[3]=PKW(P1,6), pw2); \
    VRD(3); SBAR(); GAPA(C0=__builtin_amdgcn_mfma_f32_32x32x16_bf16(kf[6],qr[3],C0,0,0,0),   P1[10],P1[11],P1[12],P1[13], pw3[0]=PKW(P1,8), pw3[1]=PKW(P1,10), pw3); \
    VRD(7); SBAR(); GAPA(C1=__builtin_amdgcn_mfma_f32_32x32x16_bf16(kf[7],qr[3],C1,0,0,0),   P1[14],P1[15],0.f,0.f,       pw3[2]=PKW(P1,12),pw3[3]=PKW(P1,14), pw3); \
    l_reg+=sacc; \
    if(GK){DMA_K((t)+3,sl_cur);} if(GV){DMA_V((t)+1,sl_next);} \
    CMASK(C0,C1,t); \
    { float a=MX3(C0[0],C0[1],C1[0]),b=MX3(C0[2],C0[3],C1[1]); a=MX3(a,C1[2],C1[3]); \
      _Pragma("unroll") for(int r=4;r<16;r+=4){a=MX3(a,C0[r],C0[r+1]);b=MX3(b,C0[r+2],C0[r+3]);a=MX3(a,C1[r],C1[r+1]);b=MX3(b,C1[r+2],C1[r+3]);} \
      float rm=__builtin_fmaxf(a,b); { auto rr=__builtin_amdgcn_permlane32_swap(__float_as_uint(rm),__float_as_uint(rm),false,false); rm=__builtin_fmaxf(__uint_as_float(rr[0]),__uint_as_float(rr[1])); } \
      resc=false; \
      if(__builtin_expect(__any(rm>(float)THRL),0)){ const float dl=__builtin_fmaxf(rm,0.f); \
        _Pragma("unroll") for(int r=0;r<16;++r){C0[r]-=dl;C1[r]-=dl;} \
        _Pragma("unroll") for(int r=0;r<16;++r)negm[r]-=dl; asm volatile("":"+v"(negm)); \
        const float f=__builtin_amdgcn_exp2f(-dl); l_reg*=f; if(hi==0)wsf[r32]=f; resc=true; } } \
    SBAR(); \
    GAPB(o[0]=__builtin_amdgcn_mfma_f32_32x32x16_bf16(PAF(0),VFR(0),o[0],0,0,0), C0,0); \
    GAPB(o[1]=__builtin_amdgcn_mfma_f32_32x32x16_bf16(PAF(0),VFR(4),o[1],0,0,0), C0,4); \
    KRD(GL,0); GAPB(o[0]=__builtin_amdgcn_mfma_f32_32x32x16_bf16(PAF(1),VFR(1),o[0],0,0,0), C0,8); \
    KRD(GL,1); GAPB(o[1]=__builtin_amdgcn_mfma_f32_32x32x16_bf16(PAF(1),VFR(5),o[1],0,0,0), C0,12); \
    KRD(GL,2); GAPB(o[0]=__builtin_amdgcn_mfma_f32_32x32x16_bf16(PAF(2),VFR(2),o[0],0,0,0), C1,0); \
    KRD(GL,3); GAPB(o[1]=__builtin_amdgcn_mfma_f32_32x32x16_bf16(PAF(2),VFR(6),o[1],0,0,0), C1,4); \
    if(GL){ kloadx(kx,kp0+sl_next); SBAR(); } GAPB(o[0]=__builtin_amdgcn_mfma_f32_32x32x16_bf16(PAF(3),VFR(3),o[0],0,0,0), C1,8); \
    GAPB(o[1]=__builtin_amdgcn_mfma_f32_32x32x16_bf16(PAF(3),VFR(7),o[1],0,0,0), C1,12); \
    }while(0)
  int t=1;
  #undef CMASK
  #define CMASK(P0,P1,t) do{}while(0)
  for(;t+5<NT;t+=2){
    STEP(pB0,pB1,pA0,pA1,t,true,true,true);     WAIT_BAR(3); RESC(); ROT();
    STEP(pA0,pA1,pB0,pB1,t+1,true,true,true);   WAIT_BAR(3); RESC(); ROT();
  }
  #undef CMASK
  #define CMASK(P0,P1,t) do{int jb_=(t)-(NT-4); if(jb_>=0)cmask(P0,P1,jb_,qrel,hi);}while(0)
  #define ENDW(tt) do{ if((tt)+3<NT){WAIT_BAR(3);} else if((tt)+2<NT){WAIT_BAR(1);} else {WAIT_BAR(0);} }while(0)
  for(;t+1<NT;t+=2){
    STEP(pB0,pB1,pA0,pA1,t,(t+3<NT),(t+1<NT),(t+1<NT));       ENDW(t);   RESC(); ROT();
    STEP(pA0,pA1,pB0,pB1,t+1,(t+4<NT),(t+2<NT),(t+2<NT));     ENDW(t+1); RESC(); ROT();
  }
  STEP(pB0,pB1,pA0,pA1,NT-1,false,false,false); RESC();
  { float sacc=pB0[0]+pB0[1]; _Pragma("unroll") for(int r=2;r<16;++r)sacc+=pB0[r]; _Pragma("unroll") for(int r=0;r<16;++r)sacc+=pB1[r]; l_reg+=sacc;
    pw0=(u32x4){PKW(pB0,0),PKW(pB0,2),PKW(pB0,4),PKW(pB0,6)};pw1=(u32x4){PKW(pB0,8),PKW(pB0,10),PKW(pB0,12),PKW(pB0,14)};pw2=(u32x4){PKW(pB1,0),PKW(pB1,2),PKW(pB1,4),PKW(pB1,6)};pw3=(u32x4){PKW(pB1,8),PKW(pB1,10),PKW(pB1,12),PKW(pB1,14)};
    SBAR(); pv(o,vb0+sl_cur,PAF(0),PAF(1),PAF(2),PAF(3)); }
  #undef PKW
  #undef PAF
  #undef VFR
  #undef PIN
  #undef MX3
  #undef GAPA
  #undef GAPB
  #undef EX
  #undef VRD
  #undef KRD
  #undef STEP
  #undef ENDW
  {auto rr=__builtin_amdgcn_permlane32_swap(__float_as_uint(l_reg),__float_as_uint(l_reg),false,false);l_reg=__uint_as_float(rr[0])+__uint_as_float(rr[1]);}
  if(hi==0)wsf[32+r32]=l_reg;asm volatile("s_waitcnt lgkmcnt(0)":::"memory");
  float rli[16];
  #pragma unroll
  for(int r=0;r<16;++r)rli[r]=__builtin_amdgcn_rcpf(wsf[32+crow(r,hi)]);
  bf16*Ow=O+(rowbase+q0+wid*QBLK)*DM+h*D;
  { bf16*stg=(bf16*)(shm+LDS_OST)+wid*2048;
    #pragma unroll
    for(int r=0;r<16;++r){const int orow=crow(r,hi);
      #pragma unroll
      for(int d0=0;d0<2;++d0)stg[orow*64+d0*32+r32]=__float2bfloat16(o[d0][r]*rli[r]);}
    asm volatile("s_waitcnt lgkmcnt(0)":::"memory");
    #pragma unroll
    for(int i=0;i<4;++i){const int row=i*8+(lane>>3),ch=lane&7; const u32x4 v=*(const u32x4*)(stg+row*64+ch*8); ATTN_STORE16(Ow+(long)row*DM+ch*8,v);} }
  asm volatile("s_waitcnt lgkmcnt(0)\n\ts_barrier":::"memory");
  #undef DMA_K
  #undef DMA_V
  #undef CMASK
  #undef START
  #undef RESC
  #undef ROT
}
constexpr int ATTN_LDS_BYTES=LDS_BYTES;
struct AttnTensors { const bf16* Q; const bf16* K; const bf16* V; bf16* O; const float* CQ; const bf16* KX; };
struct AttnUnit { int bh; int qb; };
struct StaticOrder {
  int vcu;
  __device__ __forceinline__ explicit StaticOrder(int grid,int block):vcu((block%8)*(grid/8)+block/8){}
  __device__ __forceinline__ bool next(int i,AttnUnit&u)const{ if(i>=4)return false; const int s=vcu&3; u.bh=vcu>>2; u.qb=(i==0)?s:(i==1)?7-s:(i==2)?8+s:15-s; return true; }
  __device__ __forceinline__ void a_ready(const AttnUnit&)const{}
  __device__ __forceinline__ void done(const AttnUnit&)const{}
};
template<class Sched,int THRL=8> __device__ __forceinline__ void attn_phase(char*lds,const AttnTensors&T,const Sched&S){
  AttnUnit u;
  { unsigned*z=(unsigned*)lds; for(int s=0;s<NSLOT;++s) if(threadIdx.x<256) z[(LDS_K+s*SLOTB+9216)/4+threadIdx.x]=0u; }
  asm volatile("s_waitcnt lgkmcnt(0)\n\ts_barrier":::"memory");
  for(int i=0;S.next(i,u);++i){ S.a_ready(u); attn_unit<THRL>(u.bh/NHEAD,u.bh%NHEAD,u.qb,T.Q,T.K,T.V,T.O,T.CQ,T.KX,lds); S.done(u); }
}
#undef SBAR
#undef WAIT_BAR
}
#define REP_P0 1
#define REP_WIN 1
#define REP_S5 1
#define REP_GLU 1
#define REP_MG 1
#define REP_WO 1
#define REP_RN 1
#define REP_GU 1
#define REP_DN 1
#define PROBE_SYNCS 0
#ifndef LAYER_UNROLL
#define LAYER_UNROLL _Pragma("unroll")
#endif
constexpr int NWAVES = 8;
constexpr int M = 32768, D = 1024, NPROJ = 4096, NIN = 4104, DFF = 2816, SEQL = 4096, NB = 8, NH = 8, NLAYER = 2;
constexpr float RMS_EPS = 1e-6f;
constexpr size_t MiB = 1u << 20;
constexpr size_t WS_MOD = 1 * MiB, WS_WF = 1 * MiB + 512 * 1024, WS_LAMT = 1 * MiB + 768 * 1024, WS_LF = 2 * MiB, WS_CQ = 3 * MiB, WS_KX = 4 * MiB, WS_W = 8 * MiB;
constexpr size_t W_IN = 0, W_GLU = 8 * MiB, W_MG = W_GLU + MiB / 2, W_O = W_MG + 2 * MiB, W_GU = W_O + 2 * MiB, W_DN = W_GU + 11 * MiB, W_G1 = W_DN + 11 * MiB / 2, W_S5W = W_G1 + 6 * MiB, W_LAYER = W_S5W + 4 * MiB;
constexpr size_t WS_XN = 88 * MiB, WS_PROJ = 152 * MiB, WS_HH = 152 * MiB, WS_Y = 328 * MiB, WS_ING = 408 * MiB, WS_Z = 456 * MiB, WS_MG = 408 * MiB, WS_END = 488 * MiB;
static_assert(WS_W + 2 * W_LAYER <= WS_XN, "weights fit");
constexpr int RING_OFF = 0, RING_BYTES = 131072, LDSCTL_OFF = 139264, LDS_BYTES = 147456;
#define LAS __attribute__((address_space(3)))
typedef unsigned short bf16;
typedef unsigned v4u __attribute__((ext_vector_type(4)));
typedef float f32x4 __attribute__((ext_vector_type(4)));
#define LDS_WAIT() asm volatile("s_waitcnt lgkmcnt(0)" ::: "memory")
__device__ __forceinline__ unsigned f2bf(float f) { unsigned u = __builtin_bit_cast(unsigned, f); return (u + 0x7fffu + ((u >> 16) & 1u)) >> 16; }
__device__ __forceinline__ unsigned pk2(float lo, float hi) { return f2bf(lo) | (f2bf(hi) << 16); }
__device__ __forceinline__ float bf2f(unsigned b) { return __uint_as_float(b << 16); }
__device__ __forceinline__ float wave_sum(float v) {
#pragma unroll
    for (int o = 1; o < 64; o <<= 1) v += __shfl_xor(v, o);
    return v;
}
#define XB_TMO      128
#define XB_XCNT(j)  (256  + 64 * (j))
#define XB_XSUB(j)  (1280 + 64 * (j))
#define XB_XGEN(j)  (2304 + 64 * (j))
#define XB_TOP      3328
#define XB_TOPGEN   3392
#define XCD_BAR_WORDS 3456
#define XB_SPIN_CAP (1u << 18)

__device__ __forceinline__ unsigned xb_ld(unsigned* p)              { return __hip_atomic_load(p, __ATOMIC_RELAXED, __HIP_MEMORY_SCOPE_AGENT); }
__device__ __forceinline__ unsigned xb_add(unsigned* p, unsigned v) { return __hip_atomic_fetch_add(p, v, __ATOMIC_RELAXED, __HIP_MEMORY_SCOPE_AGENT); }
__device__ __forceinline__ unsigned xb_xcc_id() { return (unsigned)__builtin_amdgcn_s_getreg((3 << 11) | 20) & 0xFu; }
#define XB_SPIN(cond, bar) do { unsigned _sp = 0; while (cond) { __builtin_amdgcn_s_sleep(1); \
    if ((++_sp & 255u) == 0u) { if (xb_ld(&(bar)[XB_TMO])) break; if (_sp > XB_SPIN_CAP) { atomicAdd(&(bar)[XB_TMO], 1u); break; } } } } while (0)

struct XcdBarrier {
    unsigned* bar; unsigned x;
    volatile LAS unsigned* st;
};

__device__ __forceinline__ XcdBarrier xcd_barrier_post(unsigned* bar, volatile LAS unsigned* st) {
    XcdBarrier b; b.bar = bar; b.x = xb_xcc_id(); b.st = st;
    if (threadIdx.x == 0) (void)xb_add(&bar[XB_XCNT(b.x)], 1u);
    return b;
}
__device__ __forceinline__ void xcd_barrier_complete(unsigned* bar, unsigned x, unsigned& nloc, unsigned& nx) {
    const unsigned G = gridDim.x * gridDim.y * gridDim.z;
    unsigned sum, cnt, mine, sp = 0u;
    for (;;) {
        sum = 0u; cnt = 0u; mine = 0u;
#pragma unroll
        for (unsigned j = 0; j < 16; ++j) { const unsigned c = xb_ld(&bar[XB_XCNT(j)]); sum += c; cnt += (c > 0u) ? 1u : 0u; mine = (j == x) ? c : mine; }
        if (sum == G) break;
        __builtin_amdgcn_s_sleep(1);
        if ((++sp & 255u) == 0u) { if (xb_ld(&bar[XB_TMO])) break; if (sp > XB_SPIN_CAP) { atomicAdd(&bar[XB_TMO], 1u); break; } }
    }
    nloc = mine > 0u ? mine : 1u; nx = cnt > 0u ? cnt : 1u;
}

__device__ __forceinline__ void xcd_barrier(const XcdBarrier& b) {
    asm volatile("s_waitcnt vmcnt(0)" ::: "memory");
    __syncthreads();
    if (threadIdx.x == 0) {
        unsigned* bar = b.bar;
        __builtin_amdgcn_s_waitcnt(0);
        unsigned nloc = b.st[0], nx = b.st[1];
        if (nloc == 0u) { xcd_barrier_complete(bar, b.x, nloc, nx); b.st[0] = nloc; b.st[1] = nx; }
        const unsigned old = xb_add(&bar[XB_XSUB(b.x)], 1u);
        const unsigned gen = old / nloc;
        if (old + 1u == (gen + 1u) * nloc) {
            __builtin_amdgcn_fence(__ATOMIC_RELEASE, "agent");
            asm volatile("s_waitcnt vmcnt(0)" ::: "memory");
            const unsigned og = xb_add(&bar[XB_TOP], 1u);
            const unsigned tg = og / nx;
            if (og + 1u == (tg + 1u) * nx) xb_add(&bar[XB_TOPGEN], 1u);
            else XB_SPIN(xb_ld(&bar[XB_TOPGEN]) == tg, bar);
            __builtin_amdgcn_fence(__ATOMIC_ACQUIRE, "agent");
            xb_add(&bar[XB_XGEN(b.x)], 1u);
            asm volatile("s_waitcnt vmcnt(0)" ::: "memory");
        } else {
            XB_SPIN(xb_ld(&bar[XB_XGEN(b.x)]) == gen, bar);
            __builtin_amdgcn_fence(__ATOMIC_ACQUIRE, "agent");
            asm volatile("s_waitcnt vmcnt(0)" ::: "memory");
        }
    }
    __syncthreads();
}

struct Args { const float* in[26]; float* out; unsigned char* ws; int ph_lo, ph_hi; };
typedef const __attribute__((address_space(4))) char* kptr_t;
__device__ __forceinline__ const float* arg_ptr(int i) { kptr_t k = (kptr_t)__builtin_amdgcn_kernarg_segment_ptr(); asm volatile("" : "+s"(k)); return *(const float* const __attribute__((address_space(4)))*)(k + 8 * i); }
#define AIN(i) arg_ptr(i)
#define AOUT ((float*)arg_ptr(26))
#define AWS ((unsigned char*)arg_ptr(27))
enum { I_X = 0, I_C, I_WADA, I_BADA, I_GPREMIX, I_GPOSTMIX, I_GPREFFN, I_GPOSTFFN, I_WIN, I_LAMRE, I_LAMIM, I_LOGDT, I_BRE, I_BIM, I_CRE, I_CIM, I_DSKIP, I_WGLU, I_BGLU, I_BF, I_WPA, I_WPB, I_WO, I_WGATE, I_WUP, I_WDOWN };

__device__ __forceinline__ void tr_item(const float* W, int ldw, int k0, int c0, bf16* WT, int ldd, int drow0, int kofs, LAS float* scr, int lane) {
#pragma unroll 8
    for (int i = 0; i < 32; ++i) { const int kk = 2 * i + (lane >> 5); scr[kk * 33 + (lane & 31)] = W[(size_t)(k0 + kk) * ldw + c0 + (lane & 31)]; }
    LDS_WAIT(); asm volatile("" ::: "memory");
    const int c = lane & 7;
#pragma unroll
    for (int j = 0; j < 4; ++j) { const int n = (lane >> 3) + 8 * j; const LAS float* s = scr + (8 * c) * 33 + n;
        v4u o; o.x = pk2(s[0 * 33], s[1 * 33]); o.y = pk2(s[2 * 33], s[3 * 33]); o.z = pk2(s[4 * 33], s[5 * 33]); o.w = pk2(s[6 * 33], s[7 * 33]);
        *(v4u*)(WT + (size_t)(drow0 + n) * ldd + kofs + k0 + 8 * c) = o; }
    LDS_WAIT(); asm volatile("" ::: "memory");
}
constexpr int TI_WIN = 16 * 64, TI_GLU = 8 * 16, TI_PA = 8 * 32, TI_O = 16 * 32, TI_FF = 16 * 88, TI_DN = 44 * 32;
constexpr int TI_LAYER = 2 * TI_WIN + TI_GLU + 2 * TI_PA + TI_O + 2 * TI_FF + TI_DN;
__device__ __forceinline__ void p0_transposes(const Args& a, LAS unsigned char* lds, int gw, int ngw, int wave, int lane) {
    LAS float* scr = (LAS float*)(lds + wave * 16384);
    for (int it = gw; it < NLAYER * TI_LAYER; it += ngw) {
        const int l = it / TI_LAYER; int r = it % TI_LAYER;
        bf16* wb = (bf16*)(AWS + WS_W + (size_t)l * W_LAYER);
        if (r < 2 * TI_WIN) { const int seg = r / TI_WIN; r %= TI_WIN; const int kb = r / 64, nb = r % 64;
            tr_item(AIN(I_WIN) + (size_t)l * D * NIN, NIN, 64 * kb, seg * 2056 + 32 * nb, (bf16*)((unsigned char*)wb + W_IN), D, seg * 2048 + 32 * nb, 0, scr, lane); continue; } r -= 2 * TI_WIN;
        if (r < TI_GLU) { const int kb = r / 16, nb = r % 16; tr_item(AIN(I_WGLU) + (size_t)l * 512 * 512, 512, 64 * kb, 32 * nb, (bf16*)((unsigned char*)wb + W_GLU), 512, 32 * nb, 0, scr, lane); continue; } r -= TI_GLU;
        if (r < 2 * TI_PA) { const int seg = r / TI_PA; r %= TI_PA; const int kb = r / 32, nb = r % 32;
            tr_item(AIN(seg ? I_WPB : I_WPA) + (size_t)l * 512 * D, D, 64 * kb, 32 * nb, (bf16*)((unsigned char*)wb + W_MG), D, 32 * nb, seg * 512, scr, lane); continue; } r -= 2 * TI_PA;
        if (r < TI_O) { const int kb = r / 32, nb = r % 32; tr_item(AIN(I_WO) + (size_t)l * D * D, D, 64 * kb, 32 * nb, (bf16*)((unsigned char*)wb + W_O), D, 32 * nb, 0, scr, lane); continue; } r -= TI_O;
        if (r < 2 * TI_FF) { const int seg = r / TI_FF; r %= TI_FF; const int kb = r / 88, nb = r % 88; const int n0 = 32 * nb;
            tr_item(AIN(seg ? I_WUP : I_WGATE) + (size_t)l * D * DFF, DFF, 64 * kb, n0, (bf16*)((unsigned char*)wb + W_GU), D, (n0 / 128) * 256 + (n0 % 128) + seg * 128, 0, scr, lane); continue; } r -= 2 * TI_FF;
        { const int kb = r / 32, nb = r % 32; tr_item(AIN(I_WDOWN) + (size_t)l * DFF * D, D, 64 * kb, 32 * nb, (bf16*)((unsigned char*)wb + W_DN), DFF, 32 * nb, 0, scr, lane); }
    }
}
__device__ __forceinline__ void p0_mod(const Args& a, LAS unsigned char* lds, int tid, int wave, int lane, int bx, int G) {
    LAS float* sc = (LAS float*)lds;
    LAS float* part = (LAS float*)(lds + 32768);
    const float* c = AIN(I_C);
    for (int i = tid; i < NB * D; i += 512) { const float v = c[i]; sc[i] = v / (1.0f + __expf(-v)); }
    __syncthreads();
    float* MOD = (float*)(AWS + WS_MOD);
    for (int it = bx; it < NLAYER * 96; it += G) {
        const int l = it / 96, col = (it % 96) * 64 + lane;
        const float* w = AIN(I_WADA) + (size_t)l * D * 6144 + col;
        float acc[8] = {0.f, 0.f, 0.f, 0.f, 0.f, 0.f, 0.f, 0.f};
#pragma unroll 4
        for (int k = 128 * wave; k < 128 * wave + 128; ++k) { const float wv = w[(size_t)k * 6144];
#pragma unroll
            for (int b = 0; b < 8; ++b) acc[b] += sc[b * D + k] * wv; }
#pragma unroll
        for (int b = 0; b < 8; ++b) part[(wave * 8 + b) * 64 + lane] = acc[b];
        __syncthreads();
        { const int b = tid >> 6; float s = 0.f;
#pragma unroll
          for (int w8 = 0; w8 < 8; ++w8) s += part[(w8 * 8 + b) * 64 + lane];
          MOD[((size_t)l * 8 + b) * 6144 + col] = s + AIN(I_BADA)[(size_t)l * 6144 + col]; }
        __syncthreads();
    }
}
__device__ __forceinline__ void p0_s5(const Args& a, LAS unsigned char* lds, int tid, int it) {
    const int l = it >> 5, g = it & 31;
    LAS float* LB = (LAS float*)lds;
    LAS float* BB = LB + 64 * 17 * 2;
    LAS float* CC = BB + 64 * 16 * 2;
    LAS float* FAC = CC + 16 * 64 * 2;
    LAS float* KERN = FAC + 128;
    const size_t lg = (size_t)l * 32 + g;
    if (tid < 64) { const int p = tid;
        const float lre = fminf(AIN(I_LAMRE)[lg * 64 + p], -1e-4f), lim = AIN(I_LAMIM)[lg * 64 + p], dt = __expf(AIN(I_LOGDT)[lg]);
        const float mag = expf(lre * dt), th = lim * dt, kk = rintf(th * 0.15915494309189535f);
        float rr = fmaf(-kk, 6.2831854820251465f, th); rr = fmaf(kk, 1.7484556e-7f, rr);
        const float br = mag * cosf(rr), bi = mag * sinf(rr);
        float pr = 1.f, pi = 0.f;
        for (int d = 0; d <= 16; ++d) { LB[(p * 17 + d) * 2] = pr; LB[(p * 17 + d) * 2 + 1] = pi; const float nr = pr * br - pi * bi, ni = pr * bi + pi * br; pr = nr; pi = ni; }
        const float nr = br - 1.f, ni = bi, den = lre * lre + lim * lim;
        FAC[2 * p] = (nr * lre + ni * lim) / den; FAC[2 * p + 1] = (ni * lre - nr * lim) / den;
        float* LT = (float*)(AWS + WS_LAMT) + (lg * 64 + p) * 2; LT[0] = LB[(p * 17 + 16) * 2]; LT[1] = LB[(p * 17 + 16) * 2 + 1];
    }
    __syncthreads();
    for (int i = tid; i < 1024; i += 512) { const int p = i >> 4;
        const float br = AIN(I_BRE)[lg * 1024 + i], bi = AIN(I_BIM)[lg * 1024 + i], fr = FAC[2 * p], fi = FAC[2 * p + 1];
        BB[2 * i] = fr * br - fi * bi; BB[2 * i + 1] = fr * bi + fi * br;
        CC[2 * i] = AIN(I_CRE)[lg * 1024 + i]; CC[2 * i + 1] = AIN(I_CIM)[lg * 1024 + i]; }
    __syncthreads();
    for (int i = tid; i < 4096; i += 512) { const int d = i >> 8, ho = (i >> 4) & 15, hi = i & 15; float s = 0.f;
        for (int p = 0; p < 64; ++p) { const float cr = CC[(ho * 64 + p) * 2], ci = CC[(ho * 64 + p) * 2 + 1], lr = LB[(p * 17 + d) * 2], li = LB[(p * 17 + d) * 2 + 1], br = BB[(p * 16 + hi) * 2], bi = BB[(p * 16 + hi) * 2 + 1];
            const float tr = cr * lr - ci * li, ti = cr * li + ci * lr; s += tr * br - ti * bi; }
        KERN[i] = s; }
    __syncthreads();
    bf16* G1 = (bf16*)(AWS + WS_W + (size_t)l * W_LAYER + W_G1) + (size_t)g * 256 * 384;
    bf16* SW = (bf16*)(AWS + WS_W + (size_t)l * W_LAYER + W_S5W) + (size_t)g * 256 * 256;
    for (int i = tid; i < 256 * 192; i += 512) { const int n = i / 192, c2 = (i % 192) * 2, t = n >> 4, ho = n & 15; float v[2];
#pragma unroll
        for (int e = 0; e < 2; ++e) { const int col = c2 + e;
            if (col < 256) { const int s = col >> 4, hi = col & 15; v[e] = (t >= s) ? KERN[((t - s) * 16 + ho) * 16 + hi] : 0.f; }
            else { const int p = (col - 256) >> 1, ri = col & 1; const float cr = CC[(ho * 64 + p) * 2], ci = CC[(ho * 64 + p) * 2 + 1], lr = LB[(p * 17 + t + 1) * 2], li = LB[(p * 17 + t + 1) * 2 + 1];
                v[e] = ri ? -(cr * li + ci * lr) : (cr * lr - ci * li); } }
        *(unsigned*)(G1 + (size_t)n * 384 + c2) = pk2(v[0], v[1]); }
    for (int i = tid; i < 256 * 128; i += 512) { const int n = i >> 7, c2 = (i & 127) * 2; float v[2];
#pragma unroll
        for (int e = 0; e < 2; ++e) { const int col = c2 + e, s = col >> 4, hi = col & 15;
            if (n < 128) { const int p = n >> 1, ri = n & 1; const float lr = LB[(p * 17 + 15 - s) * 2], li = LB[(p * 17 + 15 - s) * 2 + 1], br = BB[(p * 16 + hi) * 2], bi = BB[(p * 16 + hi) * 2 + 1];
                v[e] = ri ? (lr * bi + li * br) : (lr * br - li * bi); } else v[e] = 0.f; }
        *(unsigned*)(SW + (size_t)n * 256 + c2) = pk2(v[0], v[1]); }
    __syncthreads();
}
struct RN { const float* xin; const bf16* y; float* xout; const float* gate; const float* gpost; const float* gpre; const float* scale; const float* shift; bf16* xn; const float* bf; float* lf; };
__device__ __forceinline__ void resnorm_phase(const RN& P, const float* wf_g, LAS unsigned char* lds, int tid, int wave, int lane, int gw, int ngw) {
    LAS float* WFL = (LAS float*)lds;
    if (P.lf) { for (int i = tid; i < 2048; i += 512) ((LAS f32x4*)WFL)[i] = ((const f32x4*)wf_g)[i]; __syncthreads(); }
    for (int m = gw; m < M; m += ngw) {
        const int b = m >> 12;
        f32x4 v[4];
#pragma unroll
        for (int j = 0; j < 4; ++j) v[j] = *((const f32x4*)(P.xin + (size_t)m * D) + lane + 64 * j);
        if (P.y) {
            f32x4 yy[4]; float s = 0.f;
#pragma unroll
            for (int j = 0; j < 4; ++j) { const uint2 w = *((const uint2*)(P.y + (size_t)m * D) + lane + 64 * j); yy[j] = (f32x4){bf2f(w.x & 0xffffu), bf2f(w.x >> 16), bf2f(w.y & 0xffffu), bf2f(w.y >> 16)};
                s += (yy[j].x * yy[j].x + yy[j].y * yy[j].y) + (yy[j].z * yy[j].z + yy[j].w * yy[j].w); }
            const float rstd = rsqrtf(wave_sum(s) * (1.f / D) + RMS_EPS);
#pragma unroll
            for (int j = 0; j < 4; ++j) { const f32x4 gt = *((const f32x4*)(P.gate + (size_t)b * 6144) + lane + 64 * j), gp = *((const f32x4*)P.gpost + lane + 64 * j);
                v[j] = v[j] + gt * (yy[j] * rstd * gp); *((f32x4*)(P.xout + (size_t)m * D) + lane + 64 * j) = v[j]; }
        }
        if (P.gpre) {
            float s = 0.f;
#pragma unroll
            for (int j = 0; j < 4; ++j) s += (v[j].x * v[j].x + v[j].y * v[j].y) + (v[j].z * v[j].z + v[j].w * v[j].w);
            const float rstd = rsqrtf(wave_sum(s) * (1.f / D) + RMS_EPS);
            float fa[8] = {0.f, 0.f, 0.f, 0.f, 0.f, 0.f, 0.f, 0.f};
#pragma unroll
            for (int j = 0; j < 4; ++j) { const f32x4 gp = *((const f32x4*)P.gpre + lane + 64 * j), sc = *((const f32x4*)(P.scale + (size_t)b * 6144) + lane + 64 * j), sh = *((const f32x4*)(P.shift + (size_t)b * 6144) + lane + 64 * j);
                const f32x4 h = v[j] * rstd * gp * (sc + 1.0f) + sh;
                *((uint2*)(P.xn + (size_t)m * D) + lane + 64 * j) = make_uint2(pk2(h.x, h.y), pk2(h.z, h.w));
                if (P.lf) {
#pragma unroll
                    for (int i = 0; i < 4; ++i) { const LAS f32x4* wp = (const LAS f32x4*)(WFL + (size_t)(256 * j + 4 * lane + i) * 8); const f32x4 w0 = wp[0], w1 = wp[1]; const float hv = h[i];
                        fa[0] += hv * w0.x; fa[1] += hv * w0.y; fa[2] += hv * w0.z; fa[3] += hv * w0.w; fa[4] += hv * w1.x; fa[5] += hv * w1.y; fa[6] += hv * w1.z; fa[7] += hv * w1.w; } } }
            if (P.lf) {
#pragma unroll
                for (int q = 0; q < 8; ++q) fa[q] = wave_sum(fa[q]);
                if (lane < 8) { float f = fa[0];
#pragma unroll
                    for (int q = 1; q < 8; ++q) f = (lane == q) ? fa[q] : f;
                    const float vv = f + P.bf[lane]; P.lf[(size_t)m * 8 + lane] = fminf(vv, 0.f) - __logf(1.0f + __expf(-fabsf(vv))); } }
        }
    }
}
__device__ __forceinline__ void cumsum_item(const Args& a, LAS unsigned char* lds, int tid, int wave, int lane, int it) {
    const int b = it >> 3, hh = it & 7;
    const float* LF = (const float*)(AWS + WS_LF); float* CQ = (float*)(AWS + WS_CQ); v4u* KX = (v4u*)(AWS + WS_KX);
    LAS double* sh = (LAS double*)lds;
    double v[8], tot = 0.0;
#pragma unroll
    for (int i = 0; i < 8; ++i) { v[i] = (double)LF[((size_t)b * SEQL + 8 * tid + i) * 8 + hh]; tot += v[i]; }
    double inc = tot;
#pragma unroll
    for (int o = 1; o < 64; o <<= 1) { const double t = __shfl_up(inc, o); if (lane >= o) inc += t; }
    if (lane == 63) sh[wave] = inc;
    __syncthreads();
    double run = inc - tot;
    for (int w = 0; w < wave; ++w) run += sh[w];
#pragma unroll
    for (int i = 0; i < 8; ++i) { run += v[i]; const float c2 = (float)(run * 1.4426950408889634);
        const size_t idx = ((size_t)(b * NH + hh)) * SEQL + 8 * tid + i; CQ[idx] = c2;
        const float nv = -c2; const unsigned h1 = f2bf(nv); const float r1 = nv - bf2f(h1); const unsigned h2 = f2bf(r1); const float r2 = r1 - bf2f(h2); const unsigned h3 = f2bf(r2);
        KX[idx] = (v4u){h1 | (h2 << 16), h3, 0u, 0u}; }
    __syncthreads();
}

__global__ void __launch_bounds__(NWAVES * 64, 2) mk_fwd(Args a) {
    extern __shared__ __attribute__((aligned(16))) unsigned char lds_raw[];
    cg::grid_group grid = cg::this_grid();
    LAS unsigned char* lds = (LAS unsigned char*)lds_raw;
#define TID_DEFS const int tid = tid_now(), lane = tid & 63, wave = __builtin_amdgcn_readfirstlane(tid >> 6); const int gw = vcu * NWAVES + wave, ngw = G * NWAVES; (void)gw; (void)ngw; (void)lane
    const int G = gridDim.x, bx = blockIdx.x;
    const int vcu = (G % 8 == 0) ? (bx % 8) * (G / 8) + bx / 8 : bx;
#define WS_DEFS unsigned char* ws = AWS; float* MOD = (float*)(ws + WS_MOD); bf16* XN = (bf16*)(ws + WS_XN); bf16* PROJ = (bf16*)(ws + WS_PROJ); bf16* HH = (bf16*)(ws + WS_HH); bf16* YB = (bf16*)(ws + WS_Y); \
    bf16* ING = (bf16*)(ws + WS_ING); bf16* ZB = (bf16*)(ws + WS_Z); bf16* MG = (bf16*)(ws + WS_MG); (void)MOD; (void)XN; (void)PROJ; (void)HH; (void)YB; (void)ING; (void)ZB; (void)MG
#ifndef PHASE_MASK
#define PHASE_MASK 0x7ff
#endif
#define IN(p) (a.ph_lo <= (p) && (p) < a.ph_hi)
    { const int t0 = tid_now(); if (t0 < 64) ((LAS unsigned*)(lds + LDSCTL_OFF))[t0] = 0u;
      if (bx == 0 && a.ph_lo == 0) { unsigned* bw = (unsigned*)AWS; for (int i = t0; i < XCD_BAR_WORDS; i += 512) bw[i] = 0u; }
      __syncthreads(); }
#define EN(k) (((PHASE_MASK) >> (k)) & 1)
#define SEAM(p) do { if (IN(p) && IN((p) + 1)) { if ((p) == 0) { grid.sync(); (void)xcd_barrier_post((unsigned*)AWS, (volatile LAS unsigned*)(lds + LDSCTL_OFF + 32)); } \
        else { XcdBarrier xb_; xb_.bar = (unsigned*)AWS; xb_.x = xb_xcc_id(); xb_.st = (volatile LAS unsigned*)(lds + LDSCTL_OFF + 32); xcd_barrier(xb_); } } } while (0)
    if (EN(9) && IN(0)) {
        TID_DEFS; WS_DEFS;
        for (int rp = 0; rp < REP_P0; ++rp) {
        p0_mod(a, lds, tid, wave, lane, bx, G);
        for (int it = G - 1 - bx; it < NLAYER * 32; it += G) p0_s5(a, lds, tid, it);
        __syncthreads();
        p0_transposes(a, lds, gw, ngw, wave, lane);
        for (int i = bx * 512 + tid; i < NLAYER * D * 8; i += G * 512) { const int l = i / (D * 8), r = i % (D * 8); ((float*)(ws + WS_WF))[i] = AIN(I_WIN)[(size_t)l * D * NIN + (size_t)(r >> 3) * NIN + 2048 + (r & 7)]; }
        __syncthreads(); }
    }
    SEAM(0);
    if (EN(10) && IN(1)) {
        TID_DEFS; WS_DEFS;
        RN P{AIN(I_X), nullptr, nullptr, nullptr, nullptr, AIN(I_GPREMIX), MOD + 1024, MOD, XN, AIN(I_BF), (float*)(ws + WS_LF)};
        resnorm_phase(P, (const float*)(ws + WS_WF), lds, tid, wave, lane, gw, ngw);
    }
    SEAM(1);
    for (int rp = 0; rp < PROBE_SYNCS; ++rp) SEAM(1);
    LAYER_UNROLL
    for (int l = 0; l < NLAYER; ++l) {
        const int pb = 2 + 9 * l;
#define L_DEFS WS_DEFS; unsigned char* wb = ws + WS_W + (size_t)l * W_LAYER; const float* modl = MOD + (size_t)l * 8 * 6144; (void)wb; (void)modl
        if (EN(0) && IN(pb + 0)) {
            TID_DEFS;
            L_DEFS;
            for (int it = bx; it < NB * NH; it += G) cumsum_item(a, lds, tid, wave, lane, it);
            pg8::Gemm g{XN, (const bf16*)(wb + W_IN), D, D, D}; pg8::StaticOrder S; S.init(M, NPROJ, G, bx);
            pg8::EpiWin E{PROJ, ING, attn_body::C2};
            for (int rp = 0; rp < REP_WIN; ++rp) pg8::gemm_phase<pg8::EpiWin, pg8::StaticOrder, true, true>(lds + RING_OFF, g, S, E);
        }
        SEAM(pb + 0);
        if (EN(1) && IN(pb + 1)) {
            L_DEFS;
#ifndef NO_S5
            for (int rp = 0; rp < REP_S5; ++rp) if (bx < 256) { const int g5 = bx >> 3, b5 = bx & 7;
                pg8::OneUnit S{g5 * 8 + b5, g5};
                { pg8::Gemm g{ING, (const bf16*)(wb + W_S5W), 256, 384, 256}; pg8::EpiS5E E{ING, (const float*)(ws + WS_LAMT) + ((size_t)l * 32 + g5) * 128};
                  pg8::gemm_phase<pg8::EpiS5E, pg8::OneUnit, false, true>(lds + RING_OFF, g, S, E); }
                { pg8::Gemm g{ING, (const bf16*)(wb + W_G1), 384, 384, 384}; pg8::EpiS5Main E{ING, AIN(I_DSKIP) + (size_t)l * 512, ZB};
                  pg8::gemm_phase<pg8::EpiS5Main, pg8::OneUnit, false, true>(lds + RING_OFF, g, S, E); } }
#endif
            __syncthreads();
            const attn_body::AttnTensors AT{(const attn_body::bf16*)(PROJ + 512), (const attn_body::bf16*)(PROJ + 1024), (const attn_body::bf16*)(PROJ + 1536), (attn_body::bf16*)(PROJ + 512), (const float*)(ws + WS_CQ), (const attn_body::bf16*)(ws + WS_KX)};
            const attn_body::StaticOrder S(G, bx);
#ifndef NO_ATTN
            attn_body::attn_phase<attn_body::StaticOrder>((char*)lds_raw + RING_OFF, AT, S);
#endif
        }
        SEAM(pb + 1);
        if (EN(2) && IN(pb + 2)) {
            L_DEFS;
            pg8::Gemm g{ZB, (const bf16*)(wb + W_GLU), 512, 512, 512}; pg8::StaticOrder S; S.init(M, 512, G, bx);
            pg8::EpiGlu E{ZB, AIN(I_BGLU) + (size_t)l * 512, PROJ};
            for (int rp = 0; rp < REP_GLU; ++rp) pg8::gemm_phase<pg8::EpiGlu, pg8::StaticOrder, true, true>(lds + RING_OFF, g, S, E);
        }
        SEAM(pb + 2);
        if (EN(3) && IN(pb + 3)) {
            L_DEFS;
            pg8::Gemm g{PROJ, (const bf16*)(wb + W_MG), D, NPROJ, D}; pg8::StaticOrder S; S.init(M, D, G, bx);
            pg8::EpiMerge E{PROJ, MG, 8};
            for (int rp = 0; rp < REP_MG; ++rp) pg8::gemm_phase<pg8::EpiMerge, pg8::StaticOrder, true, true>(lds + RING_OFF, g, S, E);
        }
        SEAM(pb + 3);
        if (EN(4) && IN(pb + 4)) {
            L_DEFS;
            pg8::Gemm g{MG, (const bf16*)(wb + W_O), D, D, D}; pg8::StaticOrder S; S.init(M, D, G, bx);
            pg8::EpiBf16<0> E{YB, D, nullptr, 0, 0, 1.f};
            for (int rp = 0; rp < REP_WO; ++rp) pg8::gemm_phase<pg8::EpiBf16<0>, pg8::StaticOrder, true, true>(lds + RING_OFF, g, S, E);
        }
        SEAM(pb + 4);
        if (EN(5) && IN(pb + 5)) {
            TID_DEFS;
            L_DEFS;
            RN P{l == 0 ? AIN(I_X) : AOUT, YB, AOUT, modl + 2048, AIN(I_GPOSTMIX) + (size_t)l * D, AIN(I_GPREFFN) + (size_t)l * D, modl + 4096, modl + 3072, XN, nullptr, nullptr};
            for (int rp = 0; rp < (l == 0 ? REP_RN : 1); ++rp) resnorm_phase(P, nullptr, lds, tid, wave, lane, gw, ngw);
        }
        SEAM(pb + 5);
        if (EN(6) && IN(pb + 6)) {
            L_DEFS;
            pg8::Gemm g{XN, (const bf16*)(wb + W_GU), D, D, D}; pg8::StaticOrder S; S.init(M, 2 * DFF, G, bx);
            pg8::EpiSwiglu E{HH};
            for (int rp = 0; rp < REP_GU; ++rp) pg8::gemm_phase<pg8::EpiSwiglu, pg8::StaticOrder, true, true>(lds + RING_OFF, g, S, E);
        }
        SEAM(pb + 6);
        if (EN(7) && IN(pb + 7)) {
            L_DEFS;
            pg8::Gemm g{HH, (const bf16*)(wb + W_DN), DFF, DFF, DFF}; pg8::StaticOrder S; S.init(M, D, G, bx);
            pg8::EpiBf16<0> E{YB, D, nullptr, 0, 0, 1.f};
            for (int rp = 0; rp < REP_DN; ++rp) pg8::gemm_phase<pg8::EpiBf16<0>, pg8::StaticOrder, true, true>(lds + RING_OFF, g, S, E);
        }
        SEAM(pb + 7);
        if (EN(8) && IN(pb + 8)) {
            TID_DEFS;
            L_DEFS;
            const bool nx = (l + 1 < NLAYER); const float* modn = MOD + (size_t)(l + 1) * 8 * 6144;
            RN P{AOUT, YB, AOUT, modl + 5120, AIN(I_GPOSTFFN) + (size_t)l * D, nx ? AIN(I_GPREMIX) + (size_t)(l + 1) * D : nullptr, nx ? modn + 1024 : nullptr, nx ? modn : nullptr, XN, nx ? AIN(I_BF) + (size_t)(l + 1) * 8 : nullptr, nx ? (float*)(ws + WS_LF) : nullptr};
            resnorm_phase(P, (const float*)(ws + WS_WF) + (size_t)(l + 1) * D * 8, lds, tid, wave, lane, gw, ngw);
        }
        SEAM(pb + 8);
    }
}

extern "C" void kernel_launch(void* const* d_in, const int* in_sizes, int n_in, void* d_out, int out_size, void* d_ws, size_t ws_size, hipStream_t stream) {
    static int grid = 0;
    if (grid == 0) {
        if (n_in != 26 || out_size != M * D || ws_size < WS_END) { fprintf(stderr, "kernel_launch: unexpected problem: n_in %d out %d ws %zu (need %zu)\n", n_in, out_size, ws_size, (size_t)WS_END); grid = -1; return; }
        int dev = 0, cus = 0, per_cu = 0;
        hipGetDevice(&dev); hipDeviceGetAttribute(&cus, hipDeviceAttributeMultiprocessorCount, dev);
        if (hipFuncSetAttribute((const void*)mk_fwd, hipFuncAttributeMaxDynamicSharedMemorySize, LDS_BYTES) != hipSuccess) { fprintf(stderr, "kernel_launch: hipFuncSetAttribute failed\n"); grid = -1; return; }
        hipOccupancyMaxActiveBlocksPerMultiprocessor(&per_cu, (const void*)mk_fwd, NWAVES * 64, LDS_BYTES);
        (void)hipGetLastError();
        if (per_cu < 1) per_cu = 1;
        grid = cus * per_cu;
        if (grid != 256) fprintf(stderr, "kernel_launch: grid %d (cus %d x %d): this kernel is laid out for 256 workgroups\n", grid, cus, per_cu);
    }
    if (grid < 0) return;
    Args a{};
    for (int i = 0; i < 26; ++i) a.in[i] = (const float*)d_in[i];
    a.out = (float*)d_out; a.ws = (unsigned char*)d_ws;
#ifndef MK_SPLIT
    a.ph_lo = 0; a.ph_hi = 2 + 9 * NLAYER;
    void* args[] = {&a};
    hipError_t e = hipLaunchCooperativeKernel((const void*)mk_fwd, dim3(grid), dim3(NWAVES * 64), args, LDS_BYTES, stream);
    if (e != hipSuccess) fprintf(stderr, "kernel_launch: cooperative launch failed: %s (grid %d)\n", hipGetErrorString(e), grid);
#else
    for (int ph = 0; ph < 2 + 9 * NLAYER; ++ph) { a.ph_lo = ph; a.ph_hi = ph + 1; void* args[] = {&a};
        hipError_t e = hipLaunchCooperativeKernel((const void*)mk_fwd, dim3(grid), dim3(NWAVES * 64), args, LDS_BYTES, stream);
        if (e != hipSuccess) { fprintf(stderr, "kernel_launch: launch %d failed: %s\n", ph, hipGetErrorString(e)); break; } }
#endif
}
```

```cpp
#include <hip/hip_runtime.h>
#include <hip/hip_cooperative_groups.h>
#include <cstdio>
#include <cstdint>
namespace cg = cooperative_groups;
__device__ __forceinline__ int tid_now() { int t = threadIdx.x; asm volatile("" : "+v"(t)); return t; }
namespace pg8 {
#define PG8_LAS __attribute__((address_space(3)))
typedef unsigned short bf16_t;
typedef short bf16x8 __attribute__((ext_vector_type(8)));
typedef float f32x4 __attribute__((ext_vector_type(4)));
typedef unsigned u32x4 __attribute__((ext_vector_type(4)));
constexpr int BM = 256, BK = 64, HALF = 128, HTB = HALF * BK * 2  , STAGE_BYTES = 8 * HTB, NXCD = 8, WGM = 8;

__host__ __device__ __forceinline__ int lds_byte(int r, int c) { const int st = (r >> 4) * 2 + (c >> 5), rr = r & 15, cc = c & 31, ob = rr * 64 + cc * 2; return st * 1024 + (ob ^ (((ob >> 9) & 1) << 5)); }
__host__ __device__ __forceinline__ void stage_rc(int b, int& R, int& C) { const int st = b / 1024, sb = b % 1024, swz = sb ^ (((sb >> 9) & 1) << 5); R = (st >> 1) * 16 + swz / 64; C = (st & 1) * 32 + (swz % 64) / 2; }
__host__ __device__ __forceinline__ int perm32(int rho) { const int n = rho >> 4, i = rho & 15; return 8 * (i >> 2) + 4 * n + (i & 3); }

struct Unit { int pm, pn; };
struct Gemm { const bf16_t* A; const bf16_t* Bt; int K, lda, ldb; };

struct StaticOrder {
    int nM, nN, nwg, G, c;
    __host__ __device__ void init(int M, int N, int G_, int c_) { nM = M / BM; nN = N / BM; nwg = nM * nN; G = G_; c = c_; }
    __host__ __device__ bool next(int i, Unit& u) const {
        const long L = (long)i * G + c; if (L >= nwg) return false;
        int wgid = (int)L; { const int q = nwg / NXCD, r = nwg % NXCD, xcd = wgid % NXCD, off = wgid / NXCD; wgid = (xcd < r ? xcd * (q + 1) : r * (q + 1) + (xcd - r) * q) + off; }
        const int nig = WGM * nN, gid = wgid / nig, fm = gid * WGM, gsz = (nM - fm) < WGM ? (nM - fm) : WGM;
        u.pm = fm + ((wgid % nig) % gsz); u.pn = (wgid % nig) / gsz; return true;
    }
    __device__ __forceinline__ void a_ready(const Unit&) const {}
    __device__ __forceinline__ void done(const Unit&) const {}
};

__device__ __forceinline__ unsigned cvt_pk_bf16(float lo, float hi) { unsigned r; asm volatile("v_cvt_pk_bf16_f32 %0, %1, %2" : "=v"(r) : "v"(lo), "v"(hi)); return r; }
typedef float f32x2 __attribute__((ext_vector_type(2)));
__device__ __forceinline__ f32x2 gelu_pk(f32x2 v) {
    const f32x2 av = __builtin_elementwise_abs(v), d = av * 0.2316418882f + 1.0f;
    f32x2 t; t.x = __builtin_amdgcn_rcpf(d.x); t.y = __builtin_amdgcn_rcpf(d.y);
    f32x2 q = t * 0.5307027145f + (-0.7265760135f); q = q * t + 0.7107068705f; q = q * t + (-0.142248368f); q = q * t + 0.127414796f; q = q * t;
    const f32x2 s = (v * v) * (-0.72134752044f);
    f32x2 e; e.x = __builtin_amdgcn_exp2f(s.x); e.y = __builtin_amdgcn_exp2f(s.y);
    const f32x2 m = v * (q * e), r = v - m;
    f32x2 o; o.x = v.x < 0.f ? m.x : r.x; o.y = v.y < 0.f ? m.y : r.y; return o;
}

template <int ACT  > struct EpiBf16 {
    static constexpr bool PERM = true, AFTER_DRAIN = false, HAS_MID = false; static_assert(ACT == 0 || ACT == 1, "EpiBf16: ACT is 0 (none) or 1 (gelu_pk)");
    bf16_t* O; int ldc; const float* bias; int split_cols; size_t split_stride; float scale0;
    __device__ __forceinline__ void operator()(const f32x4 (&acc)[2][2][4][2], const Unit& u, int wr, int wc, int fr, int fq) const {
        const int row0 = u.pm * BM + wr * 64 + fr; int colt = u.pn * BM; bf16_t* base = O;
        float sc = 1.f; if (split_cols) { const int t = colt / split_cols; base += (size_t)t * split_stride; colt -= t * split_cols; if (t == 0) sc = scale0; }
        const int col0 = colt + wc * 32 + 8 * fq, bcol0 = u.pn * BM + wc * 32 + 8 * fq;
        f32x4 bv[2][2];
#pragma unroll
        for (int bj = 0; bj < 2; ++bj)
#pragma unroll
            for (int n = 0; n < 2; ++n) bv[bj][n] = bias ? *(const f32x4*)(bias + bcol0 + bj * HALF + 4 * n) : (f32x4){0.f, 0.f, 0.f, 0.f};
#pragma unroll
        for (int ai = 0; ai < 2; ++ai)
#pragma unroll
            for (int m = 0; m < 4; ++m) { bf16_t* rowp = base + (size_t)(row0 + ai * HALF + m * 16) * ldc + col0;
#pragma unroll
                for (int bj = 0; bj < 2; ++bj) { f32x4 v0 = acc[ai][bj][m][0] + bv[bj][0], v1 = acc[ai][bj][m][1] + bv[bj][1];
                    if (ACT == 1) { f32x2 a = gelu_pk((f32x2){v0[0], v0[1]}), b = gelu_pk((f32x2){v0[2], v0[3]}), c = gelu_pk((f32x2){v1[0], v1[1]}), d = gelu_pk((f32x2){v1[2], v1[3]});
                        v0 = (f32x4){a.x, a.y, b.x, b.y}; v1 = (f32x4){c.x, c.y, d.x, d.y}; }
                    v0 = v0 * sc; v1 = v1 * sc; u32x4 w; w.x = cvt_pk_bf16(v0[0], v0[1]); w.y = cvt_pk_bf16(v0[2], v0[3]); w.z = cvt_pk_bf16(v1[0], v1[1]); w.w = cvt_pk_bf16(v1[2], v1[3]);
                    *(u32x4*)(rowp + bj * HALF) = w; } }
    }
};
typedef float f32x2e __attribute__((ext_vector_type(2)));
__device__ __forceinline__ float bf_lo(unsigned w) { return __uint_as_float(w << 16); }
__device__ __forceinline__ float bf_hi(unsigned w) { return __uint_as_float(w & 0xffff0000u); }
__device__ __forceinline__ void unpack8(const u32x4 w, float (&f)[8]) { f[0] = bf_lo(w.x); f[1] = bf_hi(w.x); f[2] = bf_lo(w.y); f[3] = bf_hi(w.y); f[4] = bf_lo(w.z); f[5] = bf_hi(w.z); f[6] = bf_lo(w.w); f[7] = bf_hi(w.w); }
__device__ __forceinline__ u32x4 pack8(const float (&f)[8]) { u32x4 w; w.x = cvt_pk_bf16(f[0], f[1]); w.y = cvt_pk_bf16(f[2], f[3]); w.z = cvt_pk_bf16(f[4], f[5]); w.w = cvt_pk_bf16(f[6], f[7]); return w; }
__device__ __forceinline__ float sigm(float a) { return __builtin_amdgcn_rcpf(1.0f + __builtin_amdgcn_exp2f(-1.4426950408889634f * a)); }
#define PG8_ACC8(f, ai, bj, m) do { const f32x4 _v0 = acc[ai][bj][m][0], _v1 = acc[ai][bj][m][1]; f[0] = _v0[0]; f[1] = _v0[1]; f[2] = _v0[2]; f[3] = _v0[3]; f[4] = _v1[0]; f[5] = _v1[1]; f[6] = _v1[2]; f[7] = _v1[3]; } while (0)

struct EpiWin {
    static constexpr bool PERM = true, AFTER_DRAIN = false, HAS_MID = false;
    bf16_t* proj; bf16_t* ing; float qscale;
    __device__ __forceinline__ void operator()(const f32x4 (&acc)[2][2][4][2], const Unit& u, int wr, int wc, int fr, int fq) const {
        const float sc = (u.pn == 2 || u.pn == 3) ? qscale : 1.0f;
#pragma unroll
        for (int ai = 0; ai < 2; ++ai)
#pragma unroll
            for (int m = 0; m < 4; ++m) { int row = u.pm * BM + ai * HALF + wr * 64 + m * 16 + fr; asm volatile("" : "+v"(row));
#pragma unroll
                for (int bj = 0; bj < 2; ++bj) { const int c0 = u.pn * BM + bj * HALF + wc * 32 + 8 * fq;
                    float f[8]; PG8_ACC8(f, ai, bj, m);
#pragma unroll
                    for (int j = 0; j < 8; ++j) f[j] *= sc;
                    bf16_t* dst;
                    if (u.pn < 2) { const int g = c0 >> 4, hi0 = c0 & 15, b = row >> 12, tok = row & 4095; dst = ing + ((size_t)(g * 2048 + b * 256 + (tok >> 4)) * 384 + (tok & 15) * 16 + hi0); }
                    else dst = proj + (size_t)row * 4096 + c0;
                    *(u32x4*)dst = pack8(f); asm volatile("" ::: "memory"); } }
    }
};
struct EpiS5E {
    static constexpr bool PERM = true, AFTER_DRAIN = true, HAS_MID = false;
    bf16_t* ing; const float* lamT;
    __device__ __forceinline__ void fused(f32x4 (&acc)[2][2][4][2], const Unit& u, int wr, int wc, int fr, int fq, PG8_LAS unsigned char* lds, int wid, int lane) const {
        PG8_LAS float* EL = (PG8_LAS float*)lds;
        PG8_LAS f32x2e* SEG = (PG8_LAS f32x2e*)(lds + 135168);
#pragma unroll
        for (int ai = 0; ai < 2; ++ai)
#pragma unroll
            for (int m = 0; m < 4; ++m) { PG8_LAS float* p = EL + (ai * HALF + wr * 64 + m * 16 + fr) * 132 + wc * 32 + 8 * fq;
                *(PG8_LAS f32x4*)p = acc[ai][0][m][0]; *(PG8_LAS f32x4*)(p + 4) = acc[ai][0][m][1]; }
        asm volatile("s_waitcnt lgkmcnt(0)" ::: "memory"); __builtin_amdgcn_s_barrier(); asm volatile("" ::: "memory");
        const float lr = lamT[2 * lane], li = lamT[2 * lane + 1];
        float xr = 0.f, xi = 0.f;
        for (int c = 32 * wid; c < 32 * wid + 32; ++c) { const f32x2e e = *(PG8_LAS f32x2e*)(EL + c * 132 + 2 * lane); const float nr = lr * xr - li * xi + e.x, ni = lr * xi + li * xr + e.y; xr = nr; xi = ni; }
        SEG[wid * 64 + lane] = (f32x2e){xr, xi};
        asm volatile("s_waitcnt lgkmcnt(0)" ::: "memory"); __builtin_amdgcn_s_barrier(); asm volatile("" ::: "memory");
        float pr = lr, pi = li;
#pragma unroll
        for (int s = 0; s < 5; ++s) { const float nr = pr * pr - pi * pi, ni = 2.f * pr * pi; pr = nr; pi = ni; }
        xr = 0.f; xi = 0.f;
        for (int j = 0; j < wid; ++j) { const f32x2e e = SEG[j * 64 + lane]; const float nr = pr * xr - pi * xi + e.x, ni = pr * xi + pi * xr + e.y; xr = nr; xi = ni; }
        for (int c = 32 * wid; c < 32 * wid + 32; ++c) {
            *(unsigned*)(ing + (size_t)(u.pm * BM + c) * 384 + 256 + 2 * lane) = cvt_pk_bf16(xr, xi);
            const f32x2e e = *(PG8_LAS f32x2e*)(EL + c * 132 + 2 * lane); const float nr = lr * xr - li * xi + e.x, ni = lr * xi + li * xr + e.y; xr = nr; xi = ni; }
        asm volatile("s_waitcnt vmcnt(0) lgkmcnt(0)" ::: "memory"); __builtin_amdgcn_fence(__ATOMIC_ACQUIRE, "agent"); asm volatile("s_waitcnt vmcnt(0)" ::: "memory"); __builtin_amdgcn_s_barrier(); asm volatile("" ::: "memory");
    }
};
struct EpiS5Main {
    static constexpr bool PERM = true, AFTER_DRAIN = false, HAS_MID = false;
    const bf16_t* ing; const float* dskip; bf16_t* z;
    __device__ __forceinline__ void operator()(const f32x4 (&acc)[2][2][4][2], const Unit& u, int wr, int wc, int fr, int fq) const {
        const int g = u.pn, b = u.pm & 7;
#pragma unroll
        for (int bj = 0; bj < 2; ++bj) { const int c0 = bj * HALF + wc * 32 + 8 * fq, t = c0 >> 4, ho0 = c0 & 15;
            const f32x4 d0 = *(const f32x4*)(dskip + g * 16 + ho0), d1 = *(const f32x4*)(dskip + g * 16 + ho0 + 4);
            const float dk[8] = {d0[0], d0[1], d0[2], d0[3], d1[0], d1[1], d1[2], d1[3]};
#pragma unroll
            for (int ai = 0; ai < 2; ++ai) { int cb = ai * HALF + wr * 64 + fr; asm volatile("" : "+v"(cb));
                u32x4 ld[4];
#pragma unroll
                for (int m = 0; m < 4; ++m) ld[m] = *(const u32x4*)(ing + (size_t)(u.pm * BM + cb + m * 16) * 384 + c0);
#pragma unroll
                for (int m = 0; m < 4; ++m) { const int c = cb + m * 16; float f[8], uu[8]; PG8_ACC8(f, ai, bj, m); unpack8(ld[m], uu);
#pragma unroll
                    for (int j = 0; j < 8; ++j) { const float y = f[j] + dk[j] * uu[j]; f[j] = y * sigm(1.5957691216057308f * (y + 0.044715f * y * y * y)); }
                    *(u32x4*)(z + (size_t)(b * 4096 + c * 16 + t) * 512 + g * 16 + ho0) = pack8(f); }
                asm volatile("" ::: "memory"); } }
    }
};
struct EpiGlu {
    static constexpr bool PERM = true, AFTER_DRAIN = false, HAS_MID = false;
    const bf16_t* z; const float* bglu; bf16_t* proj;
    __device__ __forceinline__ void operator()(const f32x4 (&acc)[2][2][4][2], const Unit& u, int wr, int wc, int fr, int fq) const {
#pragma unroll
        for (int bj = 0; bj < 2; ++bj) { const int c0 = u.pn * BM + bj * HALF + wc * 32 + 8 * fq;
            const f32x4 b0 = *(const f32x4*)(bglu + c0), b1 = *(const f32x4*)(bglu + c0 + 4);
            const float bb[8] = {b0[0], b0[1], b0[2], b0[3], b1[0], b1[1], b1[2], b1[3]};
#pragma unroll
            for (int ai = 0; ai < 2; ++ai) { int rb = u.pm * BM + ai * HALF + wr * 64 + fr; asm volatile("" : "+v"(rb));
                u32x4 ld[4];
#pragma unroll
                for (int m = 0; m < 4; ++m) ld[m] = *(const u32x4*)(z + (size_t)(rb + m * 16) * 512 + c0);
#pragma unroll
                for (int m = 0; m < 4; ++m) { float f[8], zz[8]; PG8_ACC8(f, ai, bj, m); unpack8(ld[m], zz);
#pragma unroll
                    for (int j = 0; j < 8; ++j) f[j] = zz[j] * sigm(f[j] + bb[j]);
                    *(u32x4*)(proj + (size_t)(rb + m * 16) * 4096 + c0) = pack8(f); }
                asm volatile("" ::: "memory"); } }
    }
};
struct EpiMerge {
    static constexpr bool PERM = true, AFTER_DRAIN = false, HAS_MID = true;
    const bf16_t* proj; bf16_t* mg; int mid_t;
    __device__ __forceinline__ void mid(f32x4 (&acc)[2][2][4][2], const Unit& u, int wr, int wc, int fr, int fq) const {
#pragma unroll
        for (int ai = 0; ai < 2; ++ai)
#pragma unroll
            for (int bj = 0; bj < 2; ++bj) { int rb = u.pm * BM + ai * HALF + wr * 64 + fr; asm volatile("" : "+v"(rb)); const int c0 = u.pn * BM + bj * HALF + wc * 32 + 8 * fq;
                u32x4 la[4], lb[4];
#pragma unroll
                for (int m = 0; m < 4; ++m) { la[m] = *(const u32x4*)(proj + (size_t)(rb + m * 16) * 4096 + 2048 + c0); lb[m] = *(const u32x4*)(proj + (size_t)(rb + m * 16) * 4096 + 3072 + c0); }
#pragma unroll
                for (int m = 0; m < 4; ++m) { float ga[8], gb[8], r[8]; unpack8(la[m], ga); unpack8(lb[m], gb);
#pragma unroll
                    for (int j = 0; j < 8; ++j) r[j] = (1.0f + __builtin_amdgcn_exp2f(-1.4426950408889634f * gb[j])) * __builtin_amdgcn_rcpf(1.0f + __builtin_amdgcn_exp2f(-1.4426950408889634f * ga[j]));
                    acc[ai][bj][m][0] *= (f32x4){r[0], r[1], r[2], r[3]}; acc[ai][bj][m][1] *= (f32x4){r[4], r[5], r[6], r[7]};
                    asm volatile("" : "+v"(acc[ai][bj][m][0]), "+v"(acc[ai][bj][m][1])); }
                asm volatile("" ::: "memory"); }
    }
    __device__ __forceinline__ void operator()(const f32x4 (&acc)[2][2][4][2], const Unit& u, int wr, int wc, int fr, int fq) const {
#pragma unroll
        for (int ai = 0; ai < 2; ++ai)
#pragma unroll
            for (int bj = 0; bj < 2; ++bj) { int rb = u.pm * BM + ai * HALF + wr * 64 + fr; asm volatile("" : "+v"(rb)); const int c0 = u.pn * BM + bj * HALF + wc * 32 + 8 * fq;
                u32x4 lb[4];
#pragma unroll
                for (int m = 0; m < 4; ++m) lb[m] = *(const u32x4*)(proj + (size_t)(rb + m * 16) * 4096 + 3072 + c0);
#pragma unroll
                for (int m = 0; m < 4; ++m) { float f[8], gb[8]; PG8_ACC8(f, ai, bj, m); unpack8(lb[m], gb);
#pragma unroll
                    for (int j = 0; j < 8; ++j) f[j] *= sigm(gb[j]);
                    *(u32x4*)(mg + (size_t)(rb + m * 16) * 1024 + c0) = pack8(f); }
                asm volatile("" ::: "memory"); }
    }
};
struct EpiSwiglu {
    static constexpr bool PERM = true, AFTER_DRAIN = false, HAS_MID = false;
    bf16_t* hh;
    __device__ __forceinline__ void operator()(const f32x4 (&acc)[2][2][4][2], const Unit& u, int wr, int wc, int fr, int fq) const {
#pragma unroll
        for (int ai = 0; ai < 2; ++ai)
#pragma unroll
            for (int m = 0; m < 4; ++m) { int row = u.pm * BM + ai * HALF + wr * 64 + m * 16 + fr; asm volatile("" : "+v"(row));
                float gt[8], up[8]; PG8_ACC8(gt, ai, 0, m); PG8_ACC8(up, ai, 1, m);
#pragma unroll
                for (int j = 0; j < 8; ++j) gt[j] = gt[j] * sigm(gt[j]) * up[j];
                *(u32x4*)(hh + (size_t)row * 2816 + u.pn * HALF + wc * 32 + 8 * fq) = pack8(gt); }
    }
};
struct OneUnit { int pm, pn;
    __device__ __forceinline__ bool next(int i, Unit& u) const { if (i) return false; u.pm = pm; u.pn = pn; return true; }
    __device__ __forceinline__ void a_ready(const Unit&) const {}
    __device__ __forceinline__ void done(const Unit&) const {} };
template <class Epi, class Sched, bool ALIGN_EPI = false, bool SP2 = false>
__device__ __forceinline__ void gemm_phase(PG8_LAS unsigned char* lds, const Gemm g, const Sched& S, const Epi& E) {
    const int tid = tid_now(), wid = __builtin_amdgcn_readfirstlane(tid >> 6), lane = tid & 63, wr = wid >> 2, wc = wid & 3, fr = lane & 15, fq = lane >> 4;
    int K = g.K; asm volatile("" : "+s"(K)); const int nt = K / BK;
    unsigned voffA[2], voffB[2];
#pragma unroll
    for (int i = 0; i < 2; ++i) { int R, C; stage_rc(tid * 16 + i * 8192, R, C); const int Rb = Epi::PERM ? ((R & ~31) + perm32(R & 31)) : R;
        voffA[i] = (unsigned)(R * g.lda + C) * 2u; voffB[i] = (unsigned)(Rb * g.ldb + C) * 2u; }
    const size_t kstep = (size_t)(BK * 2);
    const unsigned hsA = (unsigned)HALF * g.lda * 2u, hsB = (unsigned)HALF * g.ldb * 2u;
    const unsigned tsA = 2u * hsA, tsB = 2u * hsB;
    const unsigned ldsw = (unsigned)wid * 1024u;
    const int aoff = lds_byte(wr * 64 + fr, fq * 8), boff = lds_byte(wc * 32 + fr, fq * 8);
#define PG8_SA(b, h) (((b) * 2 + (h)) * HTB)
#define PG8_SB(b, h) ((4 + (b) * 2 + (h)) * HTB)
#define PG8_STAGE(bufoff, gbase, voff) do { _Pragma("unroll") for (int _i = 0; _i < 2; ++_i) \
        __builtin_amdgcn_global_load_lds((const unsigned*)((const char*)(gbase) + (voff)[_i]), (PG8_LAS unsigned*)(lds + (bufoff) + ldsw + _i * 8192), 16, 0, 0); } while (0)
#define PG8_LDA(dst, b, h) do { _Pragma("unroll") for (int m = 0; m < 4; ++m) _Pragma("unroll") for (int k = 0; k < 2; ++k) dst[m][k] = *(const PG8_LAS bf16x8*)(lds + PG8_SA(b, h) + aoff + m * 2048 + k * 1024); } while (0)
#define PG8_LDB(dst, b, h) do { _Pragma("unroll") for (int n = 0; n < 2; ++n) _Pragma("unroll") for (int k = 0; k < 2; ++k) dst[n][k] = *(const PG8_LAS bf16x8*)(lds + PG8_SB(b, h) + boff + n * 2048 + k * 1024); } while (0)
#define PG8_MMA(ai, bj, At, Bt) do { __builtin_amdgcn_s_setprio(1); _Pragma("unroll") for (int m = 0; m < 4; ++m) _Pragma("unroll") for (int n = 0; n < 2; ++n) _Pragma("unroll") for (int k = 0; k < 2; ++k) \
        acc[ai][bj][m][n] = __builtin_amdgcn_mfma_f32_16x16x32_bf16(Bt[n][k], At[m][k], acc[ai][bj][m][n], 0, 0, 0); __builtin_amdgcn_s_setprio(0); } while (0)
#define PG8_WAIT_V(n) asm volatile("s_waitcnt vmcnt(" #n ")" ::: "memory")
#define PG8_WAIT_L(n) asm volatile("s_waitcnt lgkmcnt(" #n ")" ::: "memory")
#define PG8_BAR __builtin_amdgcn_s_barrier()
#define PG8_SCHED __builtin_amdgcn_sched_barrier(0)
    Unit cur, nxt; int ui = 0;
    if (!S.next(0, cur)) return;
    f32x4 acc[2][2][4][2];
#pragma unroll
    for (int a = 0; a < 2; ++a)
#pragma unroll
        for (int b = 0; b < 2; ++b)
#pragma unroll
            for (int m = 0; m < 4; ++m)
#pragma unroll
                for (int n = 0; n < 2; ++n) acc[a][b][m][n] = (f32x4){0.f, 0.f, 0.f, 0.f};
    bf16x8 At[4][2], B0[2][2], B1[2][2];
    const char* cA = (const char*)g.A + (size_t)cur.pm * tsA; const char* cB = (const char*)g.Bt + (size_t)cur.pn * tsB;
    S.a_ready(cur);
    if constexpr (SP2) {
        PG8_STAGE(PG8_SB(0, 0), cB, voffB); PG8_STAGE(PG8_SB(0, 1), cB + hsB, voffB); PG8_STAGE(PG8_SA(0, 0), cA, voffA); PG8_STAGE(PG8_SA(0, 1), cA + hsA, voffA);
        if (wr == 1) PG8_BAR;
        PG8_WAIT_V(2); PG8_BAR;
        PG8_STAGE(PG8_SB(1, 0), cB + kstep, voffB); PG8_STAGE(PG8_SA(1, 0), cA + kstep, voffA); PG8_STAGE(PG8_SB(1, 1), cB + hsB + kstep, voffB);
        PG8_WAIT_V(6); PG8_BAR;
    } else {
        PG8_STAGE(PG8_SB(0, 0), cB, voffB); PG8_STAGE(PG8_SA(0, 0), cA, voffA); PG8_STAGE(PG8_SB(0, 1), cB + hsB, voffB); PG8_STAGE(PG8_SA(0, 1), cA + hsA, voffA);
        if (wr == 1) PG8_BAR;
        PG8_WAIT_V(4); PG8_BAR;
        PG8_STAGE(PG8_SB(1, 0), cB + kstep, voffB); PG8_STAGE(PG8_SA(1, 0), cA + kstep, voffA); PG8_STAGE(PG8_SB(1, 1), cB + hsB + kstep, voffB);
        PG8_WAIT_V(6); PG8_BAR;
    }
    for (;;) {
        const bool has_next = S.next(ui + 1, nxt);
        const char* nA = has_next ? (const char*)g.A + (size_t)nxt.pm * tsA : cA; const char* nB = has_next ? (const char*)g.Bt + (size_t)nxt.pn * tsB : cB;
        for (int t = 0; t < nt; t += 2) {
            if constexpr (Epi::HAS_MID) { if (t == E.mid_t) { const int l2 = tid_now() & 63; E.mid(acc, cur, wr, wc, l2 & 15, l2 >> 4); } }
            const bool last = (t == nt - 2);
            const char* a1 = cA + (size_t)(t + 1) * kstep;
            const char* a2 = last ? nA : cA + (size_t)(t + 2) * kstep; const char* b2 = last ? nB : cB + (size_t)(t + 2) * kstep;
            const char* a3 = a2 + kstep; const char* b3 = b2 + kstep;
            if (last && has_next) S.a_ready(nxt);
            if constexpr (SP2) {
            PG8_LDB(B0, 0, 0); PG8_LDB(B1, 0, 1); PG8_SCHED; PG8_LDA(At, 0, 0); PG8_STAGE(PG8_SA(1, 1), a1 + hsA, voffA);
            PG8_WAIT_V(8); PG8_WAIT_L(0); PG8_BAR; PG8_MMA(0, 0, At, B0); PG8_MMA(0, 1, At, B1); PG8_BAR; PG8_SCHED;
            PG8_LDA(At, 0, 1); PG8_STAGE(PG8_SB(0, 0), b2, voffB); PG8_STAGE(PG8_SB(0, 1), b2 + hsB, voffB); PG8_STAGE(PG8_SA(0, 0), a2, voffA);
            PG8_WAIT_V(8); PG8_WAIT_L(0); PG8_BAR; PG8_MMA(1, 0, At, B0); PG8_MMA(1, 1, At, B1); PG8_BAR; PG8_SCHED;
            PG8_LDB(B0, 1, 0); PG8_LDB(B1, 1, 1); PG8_SCHED; PG8_LDA(At, 1, 0); PG8_STAGE(PG8_SA(0, 1), a2 + hsA, voffA);
            PG8_WAIT_V(8); PG8_WAIT_L(0); PG8_BAR; PG8_MMA(0, 0, At, B0); PG8_MMA(0, 1, At, B1); PG8_BAR; PG8_SCHED;
            PG8_LDA(At, 1, 1); PG8_STAGE(PG8_SB(1, 0), b3, voffB); PG8_STAGE(PG8_SB(1, 1), b3 + hsB, voffB); PG8_STAGE(PG8_SA(1, 0), a3, voffA);
            PG8_WAIT_V(8); PG8_WAIT_L(0); PG8_BAR; PG8_MMA(1, 0, At, B0); PG8_MMA(1, 1, At, B1); PG8_BAR; PG8_SCHED;
            } else {
            PG8_LDB(B0, 0, 0); PG8_SCHED; PG8_LDA(At, 0, 0); PG8_STAGE(PG8_SA(1, 1), a1 + hsA, voffA);
            PG8_WAIT_L(8); PG8_BAR; PG8_WAIT_L(0); PG8_MMA(0, 0, At, B0); PG8_BAR; PG8_SCHED;
            PG8_LDB(B1, 0, 1); PG8_STAGE(PG8_SB(0, 0), b2, voffB);
            PG8_BAR; PG8_WAIT_L(0); PG8_MMA(0, 1, At, B1); PG8_BAR;
            PG8_LDA(At, 0, 1); PG8_STAGE(PG8_SA(0, 0), a2, voffA);
            PG8_BAR; PG8_WAIT_L(0); PG8_MMA(1, 0, At, B0); PG8_BAR; PG8_SCHED;
            PG8_STAGE(PG8_SB(0, 1), b2 + hsB, voffB);
            PG8_WAIT_V(6); PG8_BAR; PG8_MMA(1, 1, At, B1); PG8_BAR;
            PG8_LDB(B0, 1, 0); PG8_SCHED; PG8_LDA(At, 1, 0); PG8_STAGE(PG8_SA(0, 1), a2 + hsA, voffA);
            PG8_WAIT_L(8); PG8_BAR; PG8_WAIT_L(0); PG8_MMA(0, 0, At, B0); PG8_BAR; PG8_SCHED;
            PG8_LDB(B1, 1, 1); PG8_STAGE(PG8_SB(1, 0), b3, voffB);
            PG8_BAR; PG8_WAIT_L(0); PG8_MMA(0, 1, At, B1); PG8_BAR;
            PG8_LDA(At, 1, 1); PG8_STAGE(PG8_SA(1, 0), a3, voffA);
            PG8_BAR; PG8_WAIT_L(0); PG8_MMA(1, 0, At, B0); PG8_BAR; PG8_SCHED;
            PG8_STAGE(PG8_SB(1, 1), b3 + hsB, voffB);
            PG8_WAIT_V(6); PG8_BAR; PG8_MMA(1, 1, At, B1); PG8_BAR;
            }
        }
        if constexpr (ALIGN_EPI) { if (wr == 0) PG8_BAR; }
        if constexpr (!Epi::AFTER_DRAIN) { const int l2 = tid_now() & 63; E(acc, cur, wr, wc, l2 & 15, l2 >> 4); S.done(cur); }
        if (!has_next) break;
#pragma unroll
        for (int a = 0; a < 2; ++a)
#pragma unroll
            for (int b = 0; b < 2; ++b)
#pragma unroll
                for (int m = 0; m < 4; ++m)
#pragma unroll
                    for (int n = 0; n < 2; ++n) acc[a][b][m][n] = (f32x4){0.f, 0.f, 0.f, 0.f};
        cur = nxt; cA = nA; cB = nB; ++ui;
        if constexpr (ALIGN_EPI) { if (wr == 1) PG8_BAR; }
    }
    PG8_WAIT_V(0);
    if constexpr (!ALIGN_EPI) { if (wr == 0) PG8_BAR; }
    PG8_BAR;
    if constexpr (Epi::AFTER_DRAIN) { const int l2 = tid_now() & 63; E.fused(acc, cur, wr, wc, l2 & 15, l2 >> 4, lds, wid, l2); S.done(cur); }
#undef PG8_SA
#undef PG8_SB
#undef PG8_STAGE
#undef PG8_LDA
#undef PG8_LDB
#undef PG8_MMA
#undef PG8_WAIT_V
#undef PG8_WAIT_L
#undef PG8_BAR
#undef PG8_SCHED
}
}
#include <hip/hip_bf16.h>
#include <cmath>
namespace attn_body {
using bf16=__hip_bfloat16;
using bf16x8=__attribute__((ext_vector_type(8)))short;
using s16x4=__attribute__((ext_vector_type(4)))short;
using f32x16=__attribute__((ext_vector_type(16)))float;
using u32x4=__attribute__((ext_vector_type(4)))unsigned;
constexpr int BATCH=8,NHEAD=8,SEQ=4096,D=64,DM=4096;
constexpr int NW=8,QBLK=32,QB=QBLK*NW,KVBLK=64,NQB=SEQ/QB;
constexpr int ATTN_PITCH=DM, ATTN_UNIT_ROWS=QB;
__device__ __forceinline__ int crow(int r,int hi){return (r&3)+8*(r>>2)+4*hi;}
#define SBAR() __builtin_amdgcn_sched_barrier(0)
__device__ __forceinline__ void cmask(f32x16&p0,f32x16&p1,int jb,int qrel,int hi){
  const float NEG=-INFINITY; int kb=64*jb+4*hi;
  #pragma unroll
  for(int r=0;r<16;++r){int kv=kb+(r&3)+8*(r>>2); if(kv>qrel)p0[r]=NEG; if(kv+32>qrel)p1[r]=NEG;}
}

constexpr int NSLOT=3, SLOTB=10240;
constexpr int LDS_K=0, LDS_V=NSLOT*SLOTB, LDS_WS=2*NSLOT*SLOTB, LDS_OST=LDS_WS+NW*64*4, LDS_BYTES=LDS_OST+NW*4096;
constexpr float C2=0.125f*1.4426950408889634f;
__device__ __forceinline__ void glds16(const void*gsrc,unsigned lds_dst){unsigned keep;
  asm volatile("s_mov_b32 %0, m0\n\ts_mov_b32 m0, %2\n\ts_nop 0\n\tglobal_load_lds_dwordx4 %1, off\n\ts_mov_b32 m0, %0":"=&s"(keep):"v"(gsrc),"s"(lds_dst):"memory");}
__device__ __forceinline__ float max3f(float a,float b,float c){float r;asm("v_max3_f32 %0, %1, %2, %3":"=v"(r):"v"(a),"v"(b),"v"(c));return r;}
__device__ __forceinline__ float max2f(float a,float b){float r;asm("v_max_f32_e32 %0, %1, %2":"=v"(r):"v"(a),"v"(b));return r;}
__device__ __forceinline__ float fadd_s(float a,float b){float r;asm("v_add_f32_e32 %0, %1, %2":"=v"(r):"v"(a),"v"(b));return r;}
__device__ __forceinline__ float fsub_s(float a,float b){float r;asm("v_sub_f32_e32 %0, %1, %2":"=v"(r):"v"(a),"v"(b));return r;}
typedef float f32x2_t __attribute__((ext_vector_type(2))); typedef __bf16 bf16x2_t __attribute__((ext_vector_type(2)));
__device__ __forceinline__ unsigned cvtpk_s(float lo,float hi){f32x2_t v={lo,hi};bf16x2_t b=__builtin_convertvector(v,bf16x2_t);return __builtin_bit_cast(unsigned,b);}
#define WAIT_BAR(N) asm volatile("s_waitcnt vmcnt(" #N ") lgkmcnt(0)\n\ts_barrier":::"memory")

#define MFX(a,b,c) __builtin_amdgcn_mfma_f32_32x32x8bf16_1k(a,b,c,0,0,0)
__device__ __forceinline__ void qkt(f32x16&p0,f32x16&p1,const char*Kslot,const bf16x8*qr,const s16x4 qx,const f32x16&negm,int r32,int hi){
  const char*kb=Kslot+hi*1024+r32*16;
  #pragma unroll
  for(int d0=0;d0<4;++d0){
    const bf16x8 b0=*reinterpret_cast<const bf16x8*>(kb+d0*2048);
    const bf16x8 b1=*reinterpret_cast<const bf16x8*>(kb+d0*2048+512);
    if(d0==0){p0=__builtin_amdgcn_mfma_f32_32x32x16_bf16(b0,qr[0],negm,0,0,0);p1=__builtin_amdgcn_mfma_f32_32x32x16_bf16(b1,qr[0],negm,0,0,0);}
    else{p0=__builtin_amdgcn_mfma_f32_32x32x16_bf16(b0,qr[d0],p0,0,0,0);p1=__builtin_amdgcn_mfma_f32_32x32x16_bf16(b1,qr[d0],p1,0,0,0);}}
  { const s16x4 x0=*reinterpret_cast<const s16x4*>(kb+8192), x1=*reinterpret_cast<const s16x4*>(kb+8192+512); p0=MFX(x0,qx,p0); p1=MFX(x1,qx,p1); }
}
typedef __attribute__((address_space(3))) const char* lds_cptr;
typedef short v4i16_t __attribute__((ext_vector_type(4)));
__device__ __forceinline__ void kload8(bf16x8*kf,lds_cptr kp){
  kf[0]=*(const __attribute__((address_space(3))) bf16x8*)(kp);      kf[1]=*(const __attribute__((address_space(3))) bf16x8*)(kp+512);
  kf[2]=*(const __attribute__((address_space(3))) bf16x8*)(kp+2048); kf[3]=*(const __attribute__((address_space(3))) bf16x8*)(kp+2560);
  kf[4]=*(const __attribute__((address_space(3))) bf16x8*)(kp+4096); kf[5]=*(const __attribute__((address_space(3))) bf16x8*)(kp+4608);
  kf[6]=*(const __attribute__((address_space(3))) bf16x8*)(kp+6144); kf[7]=*(const __attribute__((address_space(3))) bf16x8*)(kp+6656);
}
__device__ __forceinline__ void kloadx(s16x4*kx,lds_cptr kp){ kx[0]=*(const __attribute__((address_space(3))) s16x4*)(kp+8192); kx[1]=*(const __attribute__((address_space(3))) s16x4*)(kp+8192+512); }
__device__ __forceinline__ void kload2(bf16x8*kf,lds_cptr kp,int j){ kf[2*j]=*(const __attribute__((address_space(3))) bf16x8*)(kp+j*2048); kf[2*j+1]=*(const __attribute__((address_space(3))) bf16x8*)(kp+j*2048+512); }
__device__ __forceinline__ s16x4 vtr(lds_cptr p){ return __builtin_bit_cast(s16x4,__builtin_amdgcn_ds_read_tr16_b64_v4i16((__attribute__((address_space(3))) v4i16_t*)p)); }
__device__ __forceinline__ float rowmax(const f32x16&p0,const f32x16&p1){
  float a=max3f(p0[0],p0[1],p1[0]),b=max3f(p0[2],p0[3],p1[1]);a=max3f(a,p1[2],p1[3]);
  #pragma unroll
  for(int r=4;r<16;r+=4){a=max3f(a,p0[r],p0[r+1]);b=max3f(b,p0[r+2],p0[r+3]);a=max3f(a,p1[r],p1[r+1]);b=max3f(b,p1[r+2],p1[r+3]);}
  const float m=max2f(a,b);
  auto rr=__builtin_amdgcn_permlane32_swap(__float_as_uint(m),__float_as_uint(m),false,false);
  return max2f(__uint_as_float(rr[0]),__uint_as_float(rr[1]));
}
__device__ __forceinline__ void pv(f32x16*o,int vb,bf16x8 pa0,bf16x8 pa1,bf16x8 pa2,bf16x8 pa3){
  #pragma unroll
  for(int d0=0;d0<2;++d0){s16x4 lo[4],hi[4];
    #pragma unroll
    for(int ks=0;ks<4;++ks){
      asm volatile("ds_read_b64_tr_b16 %0,%1 offset:%c2":"=&v"(lo[ks]):"v"(vb),"i"(d0*4096+ks*1024):"memory");
      asm volatile("ds_read_b64_tr_b16 %0,%1 offset:%c2":"=&v"(hi[ks]):"v"(vb),"i"(d0*4096+ks*1024+512):"memory");}
    asm volatile("s_waitcnt lgkmcnt(0)":::"memory");SBAR();
    #define PK(k) (bf16x8){lo[k][0],lo[k][1],lo[k][2],lo[k][3],hi[k][0],hi[k][1],hi[k][2],hi[k][3]}
    o[d0]=__builtin_amdgcn_mfma_f32_32x32x16_bf16(pa0,PK(0),o[d0],0,0,0);
    o[d0]=__builtin_amdgcn_mfma_f32_32x32x16_bf16(pa1,PK(1),o[d0],0,0,0);
    o[d0]=__builtin_amdgcn_mfma_f32_32x32x16_bf16(pa2,PK(2),o[d0],0,0,0);
    o[d0]=__builtin_amdgcn_mfma_f32_32x32x16_bf16(pa3,PK(3),o[d0],0,0,0);
    #undef PK
  }
}

#ifndef ATTN_STORE16
#define ATTN_STORE16(p,v) (*(u32x4*)(p)=(v))
#endif
template<int THRL> __device__ __forceinline__ void attn_unit(int b,int h,int qb,const bf16*Q,const bf16*__restrict__ K,const bf16*__restrict__ V,bf16*O,const float*__restrict__ CQ,const bf16*__restrict__ KX,char*shm){
  const int tid=tid_now(),lane=tid&63,r32=lane&31,hi=lane>>5; const int wid=__builtin_amdgcn_readfirstlane(tid>>6);
  const long rowbase=(long)b*SEQ; const int q0=qb*QB;
  const bf16*Qw=Q+(rowbase+q0+wid*QBLK)*DM+h*D;
  const bf16*Kh=K+rowbase*DM+h*D,*Vh=V+rowbase*DM+h*D;
  const unsigned lds0=(unsigned)(uintptr_t)shm;
  float*wsf=(float*)(shm+LDS_WS)+wid*64;
  const bf16*ksrc=Kh+(long)lane*DM+wid*8;
  const bf16*kxsrc=KX+((long)(b*NHEAD+h)*SEQ+lane)*8;
  const float cqv=CQ[(long)(b*NHEAD+h)*SEQ+q0+wid*QBLK+r32];
  const bf16*vsrc=Vh+(long)(16*(wid&3)+(lane>>2))*DM+(wid>>2)*32+(lane&3)*8;
  const unsigned kdst=lds0+LDS_K+wid*1024, vdst=lds0+LDS_V+wid*1024;
  #define DMA_K(t,slot) do{ glds16(ksrc+(long)(t)*KVBLK*DM,(unsigned)__builtin_amdgcn_readfirstlane(kdst+(slot))); glds16(kxsrc+(long)(t)*KVBLK*8,(unsigned)__builtin_amdgcn_readfirstlane(lds0+LDS_K+8192+(slot))); }while(0)
  #define DMA_V(t,slot) glds16(vsrc+(long)(t)*KVBLK*DM,(unsigned)__builtin_amdgcn_readfirstlane(vdst+(slot)))
  const int vb0=(int)(lds0+LDS_V)+((lane>>4)&1)*32+(lane&3)*8+(4*hi+((lane&15)>>2))*64;
  const char*Kbase=shm+LDS_K; bf16x8 kf[8]; s16x4 kx[2];
  const lds_cptr shm3=(lds_cptr)shm; const lds_cptr kp0=shm3+LDS_K+hi*1024+r32*16; const lds_cptr vp0=shm3+LDS_V+((lane>>4)&1)*32+(lane&3)*8+(4*hi+((lane&15)>>2))*64;
  const int NT=(q0+QB)/KVBLK;
  DMA_K(0,0);DMA_V(0,0);DMA_K(1,SLOTB);
  bf16x8 qr[4];
  s16x4 qx; { const uint2 one3=make_uint2(0x3F803F80u,0x00003F80u); qx=__builtin_bit_cast(s16x4,one3); }
  #pragma unroll
  for(int d0=0;d0<4;++d0)qr[d0]=*reinterpret_cast<const bf16x8*>(&Qw[(long)r32*DM+d0*16+hi*8]);
  float l_reg=0.f;f32x16 o[2];o[0]=f32x16{};o[1]=f32x16{};f32x16 negm;
  _Pragma("unroll") for(int r=0;r<16;++r)negm[r]=cqv; asm volatile("":"+v"(negm));
  const int qrel=wid*QBLK+r32;
  #define CMASK(P0,P1,t) do{int jb_=(t)-(NT-4); if(jb_>=0)cmask(P0,P1,jb_,qrel,hi);}while(0)
  bool resc=false;
  #define START(P0,P1) do{ const float rm=rowmax(P0,P1); resc=false; \
    { const float dl=rm; \
      _Pragma("unroll") for(int r=0;r<16;++r){P0[r]=fsub_s(P0[r],dl);P1[r]=fsub_s(P1[r],dl);} \
      _Pragma("unroll") for(int r=0;r<16;++r)negm[r]=fsub_s(negm[r],dl); asm volatile("":"+v"(negm)); } \
    _Pragma("unroll") for(int r=0;r<16;++r)P0[r]=__builtin_amdgcn_exp2f(P0[r]); }while(0)
  #define RESC() do{ if(resc){ asm volatile("s_waitcnt lgkmcnt(0)":::"memory"); \
      _Pragma("unroll") for(int d_=0;d_<2;++d_) _Pragma("unroll") for(int r=0;r<16;++r)o[d_][r]*=wsf[crow(r,hi)]; } }while(0)
  f32x16 pA0,pA1,pB0,pB1;
  int sl_prev=0,sl_cur=0,sl_next=SLOTB;
  #define ROT() do{sl_prev=sl_cur;sl_cur=sl_next;sl_next=(sl_next==(NSLOT-1)*SLOTB)?0:sl_next+SLOTB;}while(0)
  DMA_K(2,2*SLOTB);
  WAIT_BAR(5);
  qkt(pA0,pA1,Kbase,qr,qx,negm,r32,hi);asm volatile("s_nop 15\n\ts_nop 7":"+v"(pA0),"+v"(pA1));CMASK(pA0,pA1,0);
  START(pA0,pA1);
  _Pragma("unroll") for(int r=0;r<16;++r)pA1[r]=__builtin_amdgcn_exp2f(pA1[r]);
  WAIT_BAR(0);
  DMA_K(3,0);DMA_V(1,SLOTB);
  ROT();
  kload8(kf,kp0+sl_cur); kloadx(kx,kp0+sl_cur);
  WAIT_BAR(3);
  s16x4 vlo[8],vhi[8]; u32x4 pw0,pw1,pw2,pw3;
  #define PKW(P,B) cvtpk_s(P[B],P[B+1])
  #define PAF(k) __builtin_bit_cast(bf16x8,pw##k)
  #define VFR(i) (bf16x8){vlo[i][0],vlo[i][1],vlo[i][2],vlo[i][3],vhi[i][0],vhi[i][1],vhi[i][2],vhi[i][3]}
  #define PIN(x) asm volatile("":"+v"(x))
  #define MX3(a,b,c) __builtin_fmaxf(__builtin_fmaxf((a),(b)),(c))
  #define GAPA(MF,A0,A1,A2,A3,W0,W1,PW) do{ MF; sacc+=A0; sacc+=A1; sacc+=A2; sacc+=A3; PIN(sacc); W0; W1; PIN(PW); SBAR(); }while(0)
  #define EX(v) __builtin_amdgcn_exp2f(v)
  #define GAPB(MF,X,B) do{ MF; X[B]=EX(X[B]); X[B+1]=EX(X[B+1]); X[B+2]=EX(X[B+2]); X[B+3]=EX(X[B+3]); PIN(X); SBAR(); }while(0)
  #define VRD(i) do{ vlo[i]=vtr(vp_+(((i)>>2)*4096+((i)&3)*1024)); vhi[i]=vtr(vp_+(((i)>>2)*4096+((i)&3)*1024+512)); }while(0)
  #define KRD(G,j) do{ if(G){ kload2(kf,kp0+sl_next,j); SBAR(); } }while(0)
  #define STEP(C0,C1,P0,P1,t,GK,GV,GL) do{ SBAR(); \
    const lds_cptr vp_=vp0+sl_prev; \
    C0=MFX(kx[0],qx,negm); C1=MFX(kx[1],qx,negm); SBAR(); \
    VRD(0); SBAR(); float sacc=(P0[0]+P0[1]); \
    GAPA(C0=__builtin_amdgcn_mfma_f32_32x32x16_bf16(kf[0],qr[0],C0,0,0,0), P0[2],P0[3],P0[4],P0[5],     pw0[0]=PKW(P0,0), pw0[1]=PKW(P0,2), pw0); \
    VRD(4); SBAR(); GAPA(C1=__builtin_amdgcn_mfma_f32_32x32x16_bf16(kf[1],qr[0],C1,0,0,0), P0[6],P0[7],P0[8],P0[9],     pw0[2]=PKW(P0,4), pw0[3]=PKW(P0,6), pw0); \
    VRD(1); SBAR(); GAPA(C0=__builtin_amdgcn_mfma_f32_32x32x16_bf16(kf[2],qr[1],C0,0,0,0),   P0[10],P0[11],P0[12],P0[13], pw1[0]=PKW(P0,8), pw1[1]=PKW(P0,10), pw1); \
    VRD(5); SBAR(); GAPA(C1=__builtin_amdgcn_mfma_f32_32x32x16_bf16(kf[3],qr[1],C1,0,0,0),   P0[14],P0[15],P1[0],P1[1],   pw1[2]=PKW(P0,12),pw1[3]=PKW(P0,14), pw1); \
    VRD(2); SBAR(); GAPA(C0=__builtin_amdgcn_mfma_f32_32x32x16_bf16(kf[4],qr[2],C0,0,0,0),   P1[2],P1[3],P1[4],P1[5],     pw2[0]=PKW(P1,0), pw2[1]=PKW(P1,2), pw2); \
    VRD(6); SBAR(); GAPA(C1=__builtin_amdgcn_mfma_f32_32x32x16_bf16(kf[5],qr[2],C1,0,0,0),   P1[6],P1[7],P1[8],P1[9],     pw2[2]=PKW(P1,4), pw2[3]=PKW(P1,6), pw2); \
    VRD(3); SBAR(); GAPA(C0=__builtin_amdgcn_mfma_f32_32x32x16_bf16(kf[6],qr[3],C0,0,0,0),   P1[10],P1[11],P1[12],P1[13], pw3[0]=PKW(P1,8), pw3[1]=PKW(P1,10), pw3); \
    VRD(7); SBAR(); GAPA(C1=__builtin_amdgcn_mfma_f32_32x32x16_bf16(kf[7],qr[3],C1,0,0,0),   P1[14],P1[15],0.f,0.f,       pw3[2]=PKW(P1,12),pw3[3]=PKW(P1,14), pw3); \
    l_reg+=sacc; \
    if(GK){DMA_K((t)+3,sl_cur);} if(GV){DMA_V((t)+1,sl_next);} \
    CMASK(C0,C1,t); \
    { float a=MX3(C0[0],C0[1],C1[0]),b=MX3(C0[2],C0[3],C1[1]); a=MX3(a,C1[2],C1[3]); \
      _Pragma("unroll") for(int r=4;r<16;r+=4){a=MX3(a,C0[r],C0[r+1]);b=MX3(b,C0[r+2],C0[r+3]);a=MX3(a,C1[r],C1[r+1]);b=MX3(b,C1[r+2],C1[r+3]);} \
      float rm=__builtin_fmaxf(a,b); { auto rr=__builtin_amdgcn_permlane32_swap(__float_as_uint(rm),__float_as_uint(rm),false,false); rm=__builtin_fmaxf(__uint_as_float(rr[0]),__uint_as_float(rr[1])); } \
      resc=false; \
      if(__builtin_expect(__any(rm>(float)THRL),0)){ const float dl=__builtin_fmaxf(rm,0.f); \
        _Pragma("unroll") for(int r=0;r<16;++r){C0[r]-=dl;C1[r]-=dl;} \
        _Pragma("unroll") for(int r=0;r<16;++r)negm[r]-=dl; asm volatile("":"+v"(negm)); \
        const float f=__builtin_amdgcn_exp2f(-dl); l_reg*=f; if(hi==0)wsf[r32]=f; resc=true; } } \
    SBAR(); \
    GAPB(o[0]=__builtin_amdgcn_mfma_f32_32x32x16_bf16(PAF(0),VFR(0),o[0],0,0,0), C0,0); \
    GAPB(o[1]=__builtin_amdgcn_mfma_f32_32x32x16_bf16(PAF(0),VFR(4),o[1],0,0,0), C0,4); \
    KRD(GL,0); GAPB(o[0]=__builtin_amdgcn_mfma_f32_32x32x16_bf16(PAF(1),VFR(1),o[0],0,0,0), C0,8); \
    KRD(GL,1); GAPB(o[1]=__builtin_amdgcn_mfma_f32_32x32x16_bf16(PAF(1),VFR(5),o[1],0,0,0), C0,12); \
    KRD(GL,2); GAPB(o[0]=__builtin_amdgcn_mfma_f32_32x32x16_bf16(PAF(2),VFR(2),o[0],0,0,0), C1,0); \
    KRD(GL,3); GAPB(o[1]=__builtin_amdgcn_mfma_f32_32x32x16_bf16(PAF(2),VFR(6),o[1],0,0,0), C1,4); \
    if(GL){ kloadx(kx,kp0+sl_next); SBAR(); } GAPB(o[0]=__builtin_amdgcn_mfma_f32_32x32x16_bf16(PAF(3),VFR(3),o[0],0,0,0), C1,8); \
    GAPB(o[1]=__builtin_amdgcn_mfma_f32_32x32x16_bf16(PAF(3),VFR(7),o[1],0,0,0), C1,12); \
    }while(0)
  int t=1;
  #undef CMASK
  #define CMASK(P0,P1,t) do{}while(0)
  for(;t+5<NT;t+=2){
    STEP(pB0,pB1,pA0,pA1,t,true,true,true);     WAIT_BAR(3); RESC(); ROT();
    STEP(pA0,pA1,pB0,pB1,t+1,true,true,true);   WAIT_BAR(3); RESC(); ROT();
  }
  #undef CMASK
  #define CMASK(P0,P1,t) do{int jb_=(t)-(NT-4); if(jb_>=0)cmask(P0,P1,jb_,qrel,hi);}while(0)
  #define ENDW(tt) do{ if((tt)+3<NT){WAIT_BAR(3);} else if((tt)+2<NT){WAIT_BAR(1);} else {WAIT_BAR(0);} }while(0)
  for(;t+1<NT;t+=2){
    STEP(pB0,pB1,pA0,pA1,t,(t+3<NT),(t+1<NT),(t+1<NT));       ENDW(t);   RESC(); ROT();
    STEP(pA0,pA1,pB0,pB1,t+1,(t+4<NT),(t+2<NT),(t+2<NT));     ENDW(t+1); RESC(); ROT();
  }
  STEP(pB0,pB1,pA0,pA1,NT-1,false,false,false); RESC();
  { float sacc=pB0[0]+pB0[1]; _Pragma("unroll") for(int r=2;r<16;++r)sacc+=pB0[r]; _Pragma("unroll") for(int r=0;r<16;++r)sacc+=pB1[r]; l_reg+=sacc;
    pw0=(u32x4){PKW(pB0,0),PKW(pB0,2),PKW(pB0,4),PKW(pB0,6)};pw1=(u32x4){PKW(pB0,8),PKW(pB0,10),PKW(pB0,12),PKW(pB0,14)};pw2=(u32x4){PKW(pB1,0),PKW(pB1,2),PKW(pB1,4),PKW(pB1,6)};pw3=(u32x4){PKW(pB1,8),PKW(pB1,10),PKW(pB1,12),PKW(pB1,14)};
    SBAR(); pv(o,vb0+sl_cur,PAF(0),PAF(1),PAF(2),PAF(3)); }
  #undef PKW
  #undef PAF
  #undef VFR
  #undef PIN
  #undef MX3
  #undef GAPA
  #undef GAPB
  #undef EX
  #undef VRD
  #undef KRD
  #undef STEP
  #undef ENDW
  {auto rr=__builtin_amdgcn_permlane32_swap(__float_as_uint(l_reg),__float_as_uint(l_reg),false,false);l_reg=__uint_as_float(rr[0])+__uint_as_float(rr[1]);}
  if(hi==0)wsf[32+r32]=l_reg;asm volatile("s_waitcnt lgkmcnt(0)":::"memory");
  float rli[16];
  #pragma unroll
  for(int r=0;r<16;++r)rli[r]=__builtin_amdgcn_rcpf(wsf[32+crow(r,hi)]);
  bf16*Ow=O+(rowbase+q0+wid*QBLK)*DM+h*D;
  { bf16*stg=(bf16*)(shm+LDS_OST)+wid*2048;
    #pragma unroll
    for(int r=0;r<16;++r){const int orow=crow(r,hi);
      #pragma unroll
      for(int d0=0;d0<2;++d0)stg[orow*64+d0*32+r32]=__float2bfloat16(o[d0][r]*rli[r]);}
    asm volatile("s_waitcnt lgkmcnt(0)":::"memory");
    #pragma unroll
    for(int i=0;i<4;++i){const int row=i*8+(lane>>3),ch=lane&7; const u32x4 v=*(const u32x4*)(stg+row*64+ch*8); ATTN_STORE16(Ow+(long)row*DM+ch*8,v);} }
  asm volatile("s_waitcnt lgkmcnt(0)\n\ts_barrier":::"memory");
  #undef DMA_K
  #undef DMA_V
  #undef CMASK
  #undef START
  #undef RESC
  #undef ROT
}
constexpr int ATTN_LDS_BYTES=LDS_BYTES;
struct AttnTensors { const bf16* Q; const bf16* K; const bf16* V; bf16* O; const float* CQ; const bf16* KX; };
struct AttnUnit { int bh; int qb; };
struct StaticOrder {
  int vcu;
  __device__ __forceinline__ explicit StaticOrder(int grid,int block):vcu((block%8)*(grid/8)+block/8){}
  __device__ __forceinline__ bool next(int i,AttnUnit&u)const{ if(i>=4)return false; const int s=vcu&3; u.bh=vcu>>2; u.qb=(i==0)?s:(i==1)?7-s:(i==2)?8+s:15-s; return true; }
  __device__ __forceinline__ void a_ready(const AttnUnit&)const{}
  __device__ __forceinline__ void done(const AttnUnit&)const{}
};
template<class Sched,int THRL=8> __device__ __forceinline__ void attn_phase(char*lds,const AttnTensors&T,const Sched&S){
  AttnUnit u;
  { unsigned*z=(unsigned*)lds; for(int s=0;s<NSLOT;++s) if(threadIdx.x<256) z[(LDS_K+s*SLOTB+9216)/4+threadIdx.x]=0u; }
  asm volatile("s_waitcnt lgkmcnt(0)\n\ts_barrier":::"memory");
  for(int i=0;S.next(i,u);++i){ S.a_ready(u); attn_unit<THRL>(u.bh/NHEAD,u.bh%NHEAD,u.qb,T.Q,T.K,T.V,T.O,T.CQ,T.KX,lds); S.done(u); }
}
#undef SBAR
#undef WAIT_BAR
}
#define REP_P0 1
#define REP_WIN 1
#define REP_S5 1
#define REP_GLU 1
#define REP_MG 1
#define REP_WO 1
#define REP_RN 1
#define REP_GU 1
#define REP_DN 1
#define PROBE_SYNCS 0
#ifndef LAYER_UNROLL
#define LAYER_UNROLL _Pragma("unroll")
#endif
constexpr int NWAVES = 8;
constexpr int M = 32768, D = 1024, NPROJ = 4096, NIN = 4104, DFF = 2816, SEQL = 4096, NB = 8, NH = 8, NLAYER = 2;
constexpr float RMS_EPS = 1e-6f;
constexpr size_t MiB = 1u << 20;
constexpr size_t WS_MOD = 1 * MiB, WS_WF = 1 * MiB + 512 * 1024, WS_LAMT = 1 * MiB + 768 * 1024, WS_LF = 2 * MiB, WS_CQ = 3 * MiB, WS_KX = 4 * MiB, WS_W = 8 * MiB;
constexpr size_t W_IN = 0, W_GLU = 8 * MiB, W_MG = W_GLU + MiB / 2, W_O = W_MG + 2 * MiB, W_GU = W_O + 2 * MiB, W_DN = W_GU + 11 * MiB, W_G1 = W_DN + 11 * MiB / 2, W_S5W = W_G1 + 6 * MiB, W_LAYER = W_S5W + 4 * MiB;
constexpr size_t WS_XN = 88 * MiB, WS_PROJ = 152 * MiB, WS_HH = 152 * MiB, WS_Y = 328 * MiB, WS_ING = 408 * MiB, WS_Z = 456 * MiB, WS_MG = 408 * MiB, WS_END = 488 * MiB;
static_assert(WS_W + 2 * W_LAYER <= WS_XN, "weights fit");
constexpr int RING_OFF = 0, RING_BYTES = 131072, LDSCTL_OFF = 139264, LDS_BYTES = 147456;
#define LAS __attribute__((address_space(3)))
typedef unsigned short bf16;
typedef unsigned v4u __attribute__((ext_vector_type(4)));
typedef float f32x4 __attribute__((ext_vector_type(4)));
#define LDS_WAIT() asm volatile("s_waitcnt lgkmcnt(0)" ::: "memory")
__device__ __forceinline__ unsigned f2bf(float f) { unsigned u = __builtin_bit_cast(unsigned, f); return (u + 0x7fffu + ((u >> 16) & 1u)) >> 16; }
__device__ __forceinline__ unsigned pk2(float lo, float hi) { return f2bf(lo) | (f2bf(hi) << 16); }
__device__ __forceinline__ float bf2f(unsigned b) { return __uint_as_float(b << 16); }
__device__ __forceinline__ float wave_sum(float v) {
#pragma unroll
    for (int o = 1; o < 64; o <<= 1) v += __shfl_xor(v, o);
    return v;
}
#define XB_TMO      128
#define XB_XCNT(j)  (256  + 64 * (j))
#define XB_XSUB(j)  (1280 + 64 * (j))
#define XB_XGEN(j)  (2304 + 64 * (j))
#define XB_TOP      3328
#define XB_TOPGEN   3392
#define XCD_BAR_WORDS 3456
#define XB_SPIN_CAP (1u << 18)

__device__ __forceinline__ unsigned xb_ld(unsigned* p)              { return __hip_atomic_load(p, __ATOMIC_RELAXED, __HIP_MEMORY_SCOPE_AGENT); }
__device__ __forceinline__ unsigned xb_add(unsigned* p, unsigned v) { return __hip_atomic_fetch_add(p, v, __ATOMIC_RELAXED, __HIP_MEMORY_SCOPE_AGENT); }
__device__ __forceinline__ unsigned xb_xcc_id() { return (unsigned)__builtin_amdgcn_s_getreg((3 << 11) | 20) & 0xFu; }
#define XB_SPIN(cond, bar) do { unsigned _sp = 0; while (cond) { __builtin_amdgcn_s_sleep(1); \
    if ((++_sp & 255u) == 0u) { if (xb_ld(&(bar)[XB_TMO])) break; if (_sp > XB_SPIN_CAP) { atomicAdd(&(bar)[XB_TMO], 1u); break; } } } } while (0)

struct XcdBarrier {
    unsigned* bar; unsigned x;
    volatile LAS unsigned* st;
};

__device__ __forceinline__ XcdBarrier xcd_barrier_post(unsigned* bar, volatile LAS unsigned* st) {
    XcdBarrier b; b.bar = bar; b.x = xb_xcc_id(); b.st = st;
    if (threadIdx.x == 0) (void)xb_add(&bar[XB_XCNT(b.x)], 1u);
    return b;
}
__device__ __forceinline__ void xcd_barrier_complete(unsigned* bar, unsigned x, unsigned& nloc, unsigned& nx) {
    const unsigned G = gridDim.x * gridDim.y * gridDim.z;
    unsigned sum, cnt, mine, sp = 0u;
    for (;;) {
        sum = 0u; cnt = 0u; mine = 0u;
#pragma unroll
        for (unsigned j = 0; j < 16; ++j) { const unsigned c = xb_ld(&bar[XB_XCNT(j)]); sum += c; cnt += (c > 0u) ? 1u : 0u; mine = (j == x) ? c : mine; }
        if (sum == G) break;
        __builtin_amdgcn_s_sleep(1);
        if ((++sp & 255u) == 0u) { if (xb_ld(&bar[XB_TMO])) break; if (sp > XB_SPIN_CAP) { atomicAdd(&bar[XB_TMO], 1u); break; } }
    }
    nloc = mine > 0u ? mine : 1u; nx = cnt > 0u ? cnt : 1u;
}

__device__ __forceinline__ void xcd_barrier(const XcdBarrier& b) {
    asm volatile("s_waitcnt vmcnt(0)" ::: "memory");
    __syncthreads();
    if (threadIdx.x == 0) {
        unsigned* bar = b.bar;
        __builtin_amdgcn_s_waitcnt(0);
        unsigned nloc = b.st[0], nx = b.st[1];
        if (nloc == 0u) { xcd_barrier_complete(bar, b.x, nloc, nx); b.st[0] = nloc; b.st[1] = nx; }
        const unsigned old = xb_add(&bar[XB_XSUB(b.x)], 1u);
        const unsigned gen = old / nloc;
        if (old + 1u == (gen + 1u) * nloc) {
            __builtin_amdgcn_fence(__ATOMIC_RELEASE, "agent");
            asm volatile("s_waitcnt vmcnt(0)" ::: "memory");
            const unsigned og = xb_add(&bar[XB_TOP], 1u);
            const unsigned tg = og / nx;
            if (og + 1u == (tg + 1u) * nx) xb_add(&bar[XB_TOPGEN], 1u);
            else XB_SPIN(xb_ld(&bar[XB_TOPGEN]) == tg, bar);
            __builtin_amdgcn_fence(__ATOMIC_ACQUIRE, "agent");
            xb_add(&bar[XB_XGEN(b.x)], 1u);
            asm volatile("s_waitcnt vmcnt(0)" ::: "memory");
        } else {
            XB_SPIN(xb_ld(&bar[XB_XGEN(b.x)]) == gen, bar);
            __builtin_amdgcn_fence(__ATOMIC_ACQUIRE, "agent");
            asm volatile("s_waitcnt vmcnt(0)" ::: "memory");
        }
    }
    __syncthreads();
}

struct Args { const float* in[26]; float* out; unsigned char* ws; int ph_lo, ph_hi; };
typedef const __attribute__((address_space(4))) char* kptr_t;
__device__ __forceinline__ const float* arg_ptr(int i) { kptr_t k = (kptr_t)__builtin_amdgcn_kernarg_segment_ptr(); asm volatile("" : "+s"(k)); return *(const float* const __attribute__((address_space(4)))*)(k + 8 * i); }
#define AIN(i) arg_ptr(i)
#define AOUT ((float*)arg_ptr(26))
#define AWS ((unsigned char*)arg_ptr(27))
enum { I_X = 0, I_C, I_WADA, I_BADA, I_GPREMIX, I_GPOSTMIX, I_GPREFFN, I_GPOSTFFN, I_WIN, I_LAMRE, I_LAMIM, I_LOGDT, I_BRE, I_BIM, I_CRE, I_CIM, I_DSKIP, I_WGLU, I_BGLU, I_BF, I_WPA, I_WPB, I_WO, I_WGATE, I_WUP, I_WDOWN };

__device__ __forceinline__ void tr_item(const float* W, int ldw, int k0, int c0, bf16* WT, int ldd, int drow0, int kofs, LAS float* scr, int lane) {
#pragma unroll 8
    for (int i = 0; i < 32; ++i) { const int kk = 2 * i + (lane >> 5); scr[kk * 33 + (lane & 31)] = W[(size_t)(k0 + kk) * ldw + c0 + (lane & 31)]; }
    LDS_WAIT(); asm volatile("" ::: "memory");
    const int c = lane & 7;
#pragma unroll
    for (int j = 0; j < 4; ++j) { const int n = (lane >> 3) + 8 * j; const LAS float* s = scr + (8 * c) * 33 + n;
        v4u o; o.x = pk2(s[0 * 33], s[1 * 33]); o.y = pk2(s[2 * 33], s[3 * 33]); o.z = pk2(s[4 * 33], s[5 * 33]); o.w = pk2(s[6 * 33], s[7 * 33]);
        *(v4u*)(WT + (size_t)(drow0 + n) * ldd + kofs + k0 + 8 * c) = o; }
    LDS_WAIT(); asm volatile("" ::: "memory");
}
constexpr int TI_WIN = 16 * 64, TI_GLU = 8 * 16, TI_PA = 8 * 32, TI_O = 16 * 32, TI_FF = 16 * 88, TI_DN = 44 * 32;
constexpr int TI_LAYER = 2 * TI_WIN + TI_GLU + 2 * TI_PA + TI_O + 2 * TI_FF + TI_DN;
__device__ __forceinline__ void p0_transposes(const Args& a, LAS unsigned char* lds, int gw, int ngw, int wave, int lane) {
    LAS float* scr = (LAS float*)(lds + wave * 16384);
    for (int it = gw; it < NLAYER * TI_LAYER; it += ngw) {
        const int l = it / TI_LAYER; int r = it % TI_LAYER;
        bf16* wb = (bf16*)(AWS + WS_W + (size_t)l * W_LAYER);
        if (r < 2 * TI_WIN) { const int seg = r / TI_WIN; r %= TI_WIN; const int kb = r / 64, nb = r % 64;
            tr_item(AIN(I_WIN) + (size_t)l * D * NIN, NIN, 64 * kb, seg * 2056 + 32 * nb, (bf16*)((unsigned char*)wb + W_IN), D, seg * 2048 + 32 * nb, 0, scr, lane); continue; } r -= 2 * TI_WIN;
        if (r < TI_GLU) { const int kb = r / 16, nb = r % 16; tr_item(AIN(I_WGLU) + (size_t)l * 512 * 512, 512, 64 * kb, 32 * nb, (bf16*)((unsigned char*)wb + W_GLU), 512, 32 * nb, 0, scr, lane); continue; } r -= TI_GLU;
        if (r < 2 * TI_PA) { const int seg = r / TI_PA; r %= TI_PA; const int kb = r / 32, nb = r % 32;
            tr_item(AIN(seg ? I_WPB : I_WPA) + (size_t)l * 512 * D, D, 64 * kb, 32 * nb, (bf16*)((unsigned char*)wb + W_MG), D, 32 * nb, seg * 512, scr, lane); continue; } r -= 2 * TI_PA;
        if (r < TI_O) { const int kb = r / 32, nb = r % 32; tr_item(AIN(I_WO) + (size_t)l * D * D, D, 64 * kb, 32 * nb, (bf16*)((unsigned char*)wb + W_O), D, 32 * nb, 0, scr, lane); continue; } r -= TI_O;
        if (r < 2 * TI_FF) { const int seg = r / TI_FF; r %= TI_FF; const int kb = r / 88, nb = r % 88; const int n0 = 32 * nb;
            tr_item(AIN(seg ? I_WUP : I_WGATE) + (size_t)l * D * DFF, DFF, 64 * kb, n0, (bf16*)((unsigned char*)wb + W_GU), D, (n0 / 128) * 256 + (n0 % 128) + seg * 128, 0, scr, lane); continue; } r -= 2 * TI_FF;
        { const int kb = r / 32, nb = r % 32; tr_item(AIN(I_WDOWN) + (size_t)l * DFF * D, D, 64 * kb, 32 * nb, (bf16*)((unsigned char*)wb + W_DN), DFF, 32 * nb, 0, scr, lane); }
    }
}
__device__ __forceinline__ void p0_mod(const Args& a, LAS unsigned char* lds, int tid, int wave, int lane, int bx, int G) {
    LAS float* sc = (LAS float*)lds;
    LAS float* part = (LAS float*)(lds + 32768);
    const float* c = AIN(I_C);
    for (int i = tid; i < NB * D; i += 512) { const float v = c[i]; sc[i] = v / (1.0f + __expf(-v)); }
    __syncthreads();
    float* MOD = (float*)(AWS + WS_MOD);
    for (int it = bx; it < NLAYER * 96; it += G) {
        const int l = it / 96, col = (it % 96) * 64 + lane;
        const float* w = AIN(I_WADA) + (size_t)l * D * 6144 + col;
        float acc[8] = {0.f, 0.f, 0.f, 0.f, 0.f, 0.f, 0.f, 0.f};
#pragma unroll 4
        for (int k = 128 * wave; k < 128 * wave + 128; ++k) { const float wv = w[(size_t)k * 6144];
#pragma unroll
            for (int b = 0; b < 8; ++b) acc[b] += sc[b * D + k] * wv; }
#pragma unroll
        for (int b = 0; b < 8; ++b) part[(wave * 8 + b) * 64 + lane] = acc[b];
        __syncthreads();
        { const int b = tid >> 6; float s = 0.f;
#pragma unroll
          for (int w8 = 0; w8 < 8; ++w8) s += part[(w8 * 8 + b) * 64 + lane];
          MOD[((size_t)l * 8 + b) * 6144 + col] = s + AIN(I_BADA)[(size_t)l * 6144 + col]; }
        __syncthreads();
    }
}
__device__ __forceinline__ void p0_s5(const Args& a, LAS unsigned char* lds, int tid, int it) {
    const int l = it >> 5, g = it & 31;
    LAS float* LB = (LAS float*)lds;
    LAS float* BB = LB + 64 * 17 * 2;
    LAS float* CC = BB + 64 * 16 * 2;
    LAS float* FAC = CC + 16 * 64 * 2;
    LAS float* KERN = FAC + 128;
    const size_t lg = (size_t)l * 32 + g;
    if (tid < 64) { const int p = tid;
        const float lre = fminf(AIN(I_LAMRE)[lg * 64 + p], -1e-4f), lim = AIN(I_LAMIM)[lg * 64 + p], dt = __expf(AIN(I_LOGDT)[lg]);
        const float mag = expf(lre * dt), th = lim * dt, kk = rintf(th * 0.15915494309189535f);
        float rr = fmaf(-kk, 6.2831854820251465f, th); rr = fmaf(kk, 1.7484556e-7f, rr);
        const float br = mag * cosf(rr), bi = mag * sinf(rr);
        float pr = 1.f, pi = 0.f;
        for (int d = 0; d <= 16; ++d) { LB[(p * 17 + d) * 2] = pr; LB[(p * 17 + d) * 2 + 1] = pi; const float nr = pr * br - pi * bi, ni = pr * bi + pi * br; pr = nr; pi = ni; }
        const float nr = br - 1.f, ni = bi, den = lre * lre + lim * lim;
        FAC[2 * p] = (nr * lre + ni * lim) / den; FAC[2 * p + 1] = (ni * lre - nr * lim) / den;
        float* LT = (float*)(AWS + WS_LAMT) + (lg * 64 + p) * 2; LT[0] = LB[(p * 17 + 16) * 2]; LT[1] = LB[(p * 17 + 16) * 2 + 1];
    }
    __syncthreads();
    for (int i = tid; i < 1024; i += 512) { const int p = i >> 4;
        const float br = AIN(I_BRE)[lg * 1024 + i], bi = AIN(I_BIM)[lg * 1024 + i], fr = FAC[2 * p], fi = FAC[2 * p + 1];
        BB[2 * i] = fr * br - fi * bi; BB[2 * i + 1] = fr * bi + fi * br;
        CC[2 * i] = AIN(I_CRE)[lg * 1024 + i]; CC[2 * i + 1] = AIN(I_CIM)[lg * 1024 + i]; }
    __syncthreads();
    for (int i = tid; i < 4096; i += 512) { const int d = i >> 8, ho = (i >> 4) & 15, hi = i & 15; float s = 0.f;
        for (int p = 0; p < 64; ++p) { const float cr = CC[(ho * 64 + p) * 2], ci = CC[(ho * 64 + p) * 2 + 1], lr = LB[(p * 17 + d) * 2], li = LB[(p * 17 + d) * 2 + 1], br = BB[(p * 16 + hi) * 2], bi = BB[(p * 16 + hi) * 2 + 1];
            const float tr = cr * lr - ci * li, ti = cr * li + ci * lr; s += tr * br - ti * bi; }
        KERN[i] = s; }
    __syncthreads();
    bf16* G1 = (bf16*)(AWS + WS_W + (size_t)l * W_LAYER + W_G1) + (size_t)g * 256 * 384;
    bf16* SW = (bf16*)(AWS + WS_W + (size_t)l * W_LAYER + W_S5W) + (size_t)g * 256 * 256;
    for (int i = tid; i < 256 * 192; i += 512) { const int n = i / 192, c2 = (i % 192) * 2, t = n >> 4, ho = n & 15; float v[2];
#pragma unroll
        for (int e = 0; e < 2; ++e) { const int col = c2 + e;
            if (col < 256) { const int s = col >> 4, hi = col & 15; v[e] = (t >= s) ? KERN[((t - s) * 16 + ho) * 16 + hi] : 0.f; }
            else { const int p = (col - 256) >> 1, ri = col & 1; const float cr = CC[(ho * 64 + p) * 2], ci = CC[(ho * 64 + p) * 2 + 1], lr = LB[(p * 17 + t + 1) * 2], li = LB[(p * 17 + t + 1) * 2 + 1];
                v[e] = ri ? -(cr * li + ci * lr) : (cr * lr - ci * li); } }
        *(unsigned*)(G1 + (size_t)n * 384 + c2) = pk2(v[0], v[1]); }
    for (int i = tid; i < 256 * 128; i += 512) { const int n = i >> 7, c2 = (i & 127) * 2; float v[2];
#pragma unroll
        for (int e = 0; e < 2; ++e) { const int col = c2 + e, s = col >> 4, hi = col & 15;
            if (n < 128) { const int p = n >> 1, ri = n & 1; const float lr = LB[(p * 17 + 15 - s) * 2], li = LB[(p * 17 + 15 - s) * 2 + 1], br = BB[(p * 16 + hi) * 2], bi = BB[(p * 16 + hi) * 2 + 1];
                v[e] = ri ? (lr * bi + li * br) : (lr * br - li * bi); } else v[e] = 0.f; }
        *(unsigned*)(SW + (size_t)n * 256 + c2) = pk2(v[0], v[1]); }
    __syncthreads();
}
struct RN { const float* xin; const bf16* y; float* xout; const float* gate; const float* gpost; const float* gpre; const float* scale; const float* shift; bf16* xn; const float* bf; float* lf; };
__device__ __forceinline__ void resnorm_phase(const RN& P, const float* wf_g, LAS unsigned char* lds, int tid, int wave, int lane, int gw, int ngw) {
    LAS float* WFL = (LAS float*)lds;
    if (P.lf) { for (int i = tid; i < 2048; i += 512) ((LAS f32x4*)WFL)[i] = ((const f32x4*)wf_g)[i]; __syncthreads(); }
    for (int m = gw; m < M; m += ngw) {
        const int b = m >> 12;
        f32x4 v[4];
#pragma unroll
        for (int j = 0; j < 4; ++j) v[j] = *((const f32x4*)(P.xin + (size_t)m * D) + lane + 64 * j);
        if (P.y) {
            f32x4 yy[4]; float s = 0.f;
#pragma unroll
            for (int j = 0; j < 4; ++j) { const uint2 w = *((const uint2*)(P.y + (size_t)m * D) + lane + 64 * j); yy[j] = (f32x4){bf2f(w.x & 0xffffu), bf2f(w.x >> 16), bf2f(w.y & 0xffffu), bf2f(w.y >> 16)};
                s += (yy[j].x * yy[j].x + yy[j].y * yy[j].y) + (yy[j].z * yy[j].z + yy[j].w * yy[j].w); }
            const float rstd = rsqrtf(wave_sum(s) * (1.f / D) + RMS_EPS);
#pragma unroll
            for (int j = 0; j < 4; ++j) { const f32x4 gt = *((const f32x4*)(P.gate + (size_t)b * 6144) + lane + 64 * j), gp = *((const f32x4*)P.gpost + lane + 64 * j);
                v[j] = v[j] + gt * (yy[j] * rstd * gp); *((f32x4*)(P.xout + (size_t)m * D) + lane + 64 * j) = v[j]; }
        }
        if (P.gpre) {
            float s = 0.f;
#pragma unroll
            for (int j = 0; j < 4; ++j) s += (v[j].x * v[j].x + v[j].y * v[j].y) + (v[j].z * v[j].z + v[j].w * v[j].w);
            const float rstd = rsqrtf(wave_sum(s) * (1.f / D) + RMS_EPS);
            float fa[8] = {0.f, 0.f, 0.f, 0.f, 0.f, 0.f, 0.f, 0.f};
#pragma unroll
            for (int j = 0; j < 4; ++j) { const f32x4 gp = *((const f32x4*)P.gpre + lane + 64 * j), sc = *((const f32x4*)(P.scale + (size_t)b * 6144) + lane + 64 * j), sh = *((const f32x4*)(P.shift + (size_t)b * 6144) + lane + 64 * j);
                const f32x4 h = v[j] * rstd * gp * (sc + 1.0f) + sh;
                *((uint2*)(P.xn + (size_t)m * D) + lane + 64 * j) = make_uint2(pk2(h.x, h.y), pk2(h.z, h.w));
                if (P.lf) {
#pragma unroll
                    for (int i = 0; i < 4; ++i) { const LAS f32x4* wp = (const LAS f32x4*)(WFL + (size_t)(256 * j + 4 * lane + i) * 8); const f32x4 w0 = wp[0], w1 = wp[1]; const float hv = h[i];
                        fa[0] += hv * w0.x; fa[1] += hv * w0.y; fa[2] += hv * w0.z; fa[3] += hv * w0.w; fa[4] += hv * w1.x; fa[5] += hv * w1.y; fa[6] += hv * w1.z; fa[7] += hv * w1.w; } } }
            if (P.lf) {
#pragma unroll
                for (int q = 0; q < 8; ++q) fa[q] = wave_sum(fa[q]);
                if (lane < 8) { float f = fa[0];
#pragma unroll
                    for (int q = 1; q < 8; ++q) f = (lane == q) ? fa[q] : f;
                    const float vv = f + P.bf[lane]; P.lf[(size_t)m * 8 + lane] = fminf(vv, 0.f) - __logf(1.0f + __expf(-fabsf(vv))); } }
        }
    }
}
__device__ __forceinline__ void cumsum_item(const Args& a, LAS unsigned char* lds, int tid, int wave, int lane, int it) {
    const int b = it >> 3, hh = it & 7;
    const float* LF = (const float*)(AWS + WS_LF); float* CQ = (float*)(AWS + WS_CQ); v4u* KX = (v4u*)(AWS + WS_KX);
    LAS double* sh = (LAS double*)lds;
    double v[8], tot = 0.0;
#pragma unroll
    for (int i = 0; i < 8; ++i) { v[i] = (double)LF[((size_t)b * SEQL + 8 * tid + i) * 8 + hh]; tot += v[i]; }
    double inc = tot;
#pragma unroll
    for (int o = 1; o < 64; o <<= 1) { const double t = __shfl_up(inc, o); if (lane >= o) inc += t; }
    if (lane == 63) sh[wave] = inc;
    __syncthreads();
    double run = inc - tot;
    for (int w = 0; w < wave; ++w) run += sh[w];
#pragma unroll
    for (int i = 0; i < 8; ++i) { run += v[i]; const float c2 = (float)(run * 1.4426950408889634);
        const size_t idx = ((size_t)(b * NH + hh)) * SEQL + 8 * tid + i; CQ[idx] = c2;
        const float nv = -c2; const unsigned h1 = f2bf(nv); const float r1 = nv - bf2f(h1); const unsigned h2 = f2bf(r1); const float r2 = r1 - bf2f(h2); const unsigned h3 = f2bf(r2);
        KX[idx] = (v4u){h1 | (h2 << 16), h3, 0u, 0u}; }
    __syncthreads();
}

__global__ void __launch_bounds__(NWAVES * 64, 2) mk_fwd(Args a) {
    extern __shared__ __attribute__((aligned(16))) unsigned char lds_raw[];
    cg::grid_group grid = cg::this_grid();
    LAS unsigned char* lds = (LAS unsigned char*)lds_raw;
#define TID_DEFS const int tid = tid_now(), lane = tid & 63, wave = __builtin_amdgcn_readfirstlane(tid >> 6); const int gw = vcu * NWAVES + wave, ngw = G * NWAVES; (void)gw; (void)ngw; (void)lane
    const int G = gridDim.x, bx = blockIdx.x;
    const int vcu = (G % 8 == 0) ? (bx % 8) * (G / 8) + bx / 8 : bx;
#define WS_DEFS unsigned char* ws = AWS; float* MOD = (float*)(ws + WS_MOD); bf16* XN = (bf16*)(ws + WS_XN); bf16* PROJ = (bf16*)(ws + WS_PROJ); bf16* HH = (bf16*)(ws + WS_HH); bf16* YB = (bf16*)(ws + WS_Y); \
    bf16* ING = (bf16*)(ws + WS_ING); bf16* ZB = (bf16*)(ws + WS_Z); bf16* MG = (bf16*)(ws + WS_MG); (void)MOD; (void)XN; (void)PROJ; (void)HH; (void)YB; (void)ING; (void)ZB; (void)MG
#ifndef PHASE_MASK
#define PHASE_MASK 0x7ff
#endif
#define IN(p) (a.ph_lo <= (p) && (p) < a.ph_hi)
    { const int t0 = tid_now(); if (t0 < 64) ((LAS unsigned*)(lds + LDSCTL_OFF))[t0] = 0u;
      if (bx == 0 && a.ph_lo == 0) { unsigned* bw = (unsigned*)AWS; for (int i = t0; i < XCD_BAR_WORDS; i += 512) bw[i] = 0u; }
      __syncthreads(); }
#define EN(k) (((PHASE_MASK) >> (k)) & 1)
#define SEAM(p) do { if (IN(p) && IN((p) + 1)) { if ((p) == 0) { grid.sync(); (void)xcd_barrier_post((unsigned*)AWS, (volatile LAS unsigned*)(lds + LDSCTL_OFF + 32)); } \
        else { XcdBarrier xb_; xb_.bar = (unsigned*)AWS; xb_.x = xb_xcc_id(); xb_.st = (volatile LAS unsigned*)(lds + LDSCTL_OFF + 32); xcd_barrier(xb_); } } } while (0)
    if (EN(9) && IN(0)) {
        TID_DEFS; WS_DEFS;
        for (int rp = 0; rp < REP_P0; ++rp) {
        p0_mod(a, lds, tid, wave, lane, bx, G);
        for (int it = G - 1 - bx; it < NLAYER * 32; it += G) p0_s5(a, lds, tid, it);
        __syncthreads();
        p0_transposes(a, lds, gw, ngw, wave, lane);
        for (int i = bx * 512 + tid; i < NLAYER * D * 8; i += G * 512) { const int l = i / (D * 8), r = i % (D * 8); ((float*)(ws + WS_WF))[i] = AIN(I_WIN)[(size_t)l * D * NIN + (size_t)(r >> 3) * NIN + 2048 + (r & 7)]; }
        __syncthreads(); }
    }
    SEAM(0);
    if (EN(10) && IN(1)) {
        TID_DEFS; WS_DEFS;
        RN P{AIN(I_X), nullptr, nullptr, nullptr, nullptr, AIN(I_GPREMIX), MOD + 1024, MOD, XN, AIN(I_BF), (float*)(ws + WS_LF)};
        resnorm_phase(P, (const float*)(ws + WS_WF), lds, tid, wave, lane, gw, ngw);
    }
    SEAM(1);
    for (int rp = 0; rp < PROBE_SYNCS; ++rp) SEAM(1);
    LAYER_UNROLL
    for (int l = 0; l < NLAYER; ++l) {
        const int pb = 2 + 9 * l;
#define L_DEFS WS_DEFS; unsigned char* wb = ws + WS_W + (size_t)l * W_LAYER; const float* modl = MOD + (size_t)l * 8 * 6144; (void)wb; (void)modl
        if (EN(0) && IN(pb + 0)) {
            TID_DEFS;
            L_DEFS;
            for (int it = bx; it < NB * NH; it += G) cumsum_item(a, lds, tid, wave, lane, it);
            pg8::Gemm g{XN, (const bf16*)(wb + W_IN), D, D, D}; pg8::StaticOrder S; S.init(M, NPROJ, G, bx);
            pg8::EpiWin E{PROJ, ING, attn_body::C2};
            for (int rp = 0; rp < REP_WIN; ++rp) pg8::gemm_phase<pg8::EpiWin, pg8::StaticOrder, true, true>(lds + RING_OFF, g, S, E);
        }
        SEAM(pb + 0);
        if (EN(1) && IN(pb + 1)) {
            L_DEFS;
#ifndef NO_S5
            for (int rp = 0; rp < REP_S5; ++rp) if (bx < 256) { const int g5 = bx >> 3, b5 = bx & 7;
                pg8::OneUnit S{g5 * 8 + b5, g5};
                { pg8::Gemm g{ING, (const bf16*)(wb + W_S5W), 256, 384, 256}; pg8::EpiS5E E{ING, (const float*)(ws + WS_LAMT) + ((size_t)l * 32 + g5) * 128};
                  pg8::gemm_phase<pg8::EpiS5E, pg8::OneUnit, false, true>(lds + RING_OFF, g, S, E); }
                { pg8::Gemm g{ING, (const bf16*)(wb + W_G1), 384, 384, 384}; pg8::EpiS5Main E{ING, AIN(I_DSKIP) + (size_t)l * 512, ZB};
                  pg8::gemm_phase<pg8::EpiS5Main, pg8::OneUnit, false, true>(lds + RING_OFF, g, S, E); } }
#endif
            __syncthreads();
            const attn_body::AttnTensors AT{(const attn_body::bf16*)(PROJ + 512), (const attn_body::bf16*)(PROJ + 1024), (const attn_body::bf16*)(PROJ + 1536), (attn_body::bf16*)(PROJ + 512), (const float*)(ws + WS_CQ), (const attn_body::bf16*)(ws + WS_KX)};
            const attn_body::StaticOrder S(G, bx);
#ifndef NO_ATTN
            attn_body::attn_phase<attn_body::StaticOrder>((char*)lds_raw + RING_OFF, AT, S);
#endif
        }
        SEAM(pb + 1);
        if (EN(2) && IN(pb + 2)) {
            L_DEFS;
            pg8::Gemm g{ZB, (const bf16*)(wb + W_GLU), 512, 512, 512}; pg8::StaticOrder S; S.init(M, 512, G, bx);
            pg8::EpiGlu E{ZB, AIN(I_BGLU) + (size_t)l * 512, PROJ};
            for (int rp = 0; rp < REP_GLU; ++rp) pg8::gemm_phase<pg8::EpiGlu, pg8::StaticOrder, true, true>(lds + RING_OFF, g, S, E);
        }
        SEAM(pb + 2);
        if (EN(3) && IN(pb + 3)) {
            L_DEFS;
            pg8::Gemm g{PROJ, (const bf16*)(wb + W_MG), D, NPROJ, D}; pg8::StaticOrder S; S.init(M, D, G, bx);
            pg8::EpiMerge E{PROJ, MG, 8};
            for (int rp = 0; rp < REP_MG; ++rp) pg8::gemm_phase<pg8::EpiMerge, pg8::StaticOrder, true, true>(lds + RING_OFF, g, S, E);
        }
        SEAM(pb + 3);
        if (EN(4) && IN(pb + 4)) {
            L_DEFS;
            pg8::Gemm g{MG, (const bf16*)(wb + W_O), D, D, D}; pg8::StaticOrder S; S.init(M, D, G, bx);
            pg8::EpiBf16<0> E{YB, D, nullptr, 0, 0, 1.f};
            for (int rp = 0; rp < REP_WO; ++rp) pg8::gemm_phase<pg8::EpiBf16<0>, pg8::StaticOrder, true, true>(lds + RING_OFF, g, S, E);
        }
        SEAM(pb + 4);
        if (EN(5) && IN(pb + 5)) {
            TID_DEFS;
            L_DEFS;
            RN P{l == 0 ? AIN(I_X) : AOUT, YB, AOUT, modl + 2048, AIN(I_GPOSTMIX) + (size_t)l * D, AIN(I_GPREFFN) + (size_t)l * D, modl + 4096, modl + 3072, XN, nullptr, nullptr};
            for (int rp = 0; rp < (l == 0 ? REP_RN : 1); ++rp) resnorm_phase(P, nullptr, lds, tid, wave, lane, gw, ngw);
        }
        SEAM(pb + 5);
        if (EN(6) && IN(pb + 6)) {
            L_DEFS;
            pg8::Gemm g{XN, (const bf16*)(wb + W_GU), D, D, D}; pg8::StaticOrder S; S.init(M, 2 * DFF, G, bx);
            pg8::EpiSwiglu E{HH};
            for (int rp = 0; rp < REP_GU; ++rp) pg8::gemm_phase<pg8::EpiSwiglu, pg8::StaticOrder, true, true>(lds + RING_OFF, g, S, E);
        }
        SEAM(pb + 6);
        if (EN(7) && IN(pb + 7)) {
            L_DEFS;
            pg8::Gemm g{HH, (const bf16*)(wb + W_DN), DFF, DFF, DFF}; pg8::StaticOrder S; S.init(M, D, G, bx);
            pg8::EpiBf16<0> E{YB, D, nullptr, 0, 0, 1.f};
            for (int rp = 0; rp < REP_DN; ++rp) pg8::gemm_phase<pg8::EpiBf16<0>, pg8::StaticOrder, true, true>(lds + RING_OFF, g, S, E);
        }
        SEAM(pb + 7);
        if (EN(8) && IN(pb + 8)) {
            TID_DEFS;
            L_DEFS;
            const bool nx = (l + 1 < NLAYER); const float* modn = MOD + (size_t)(l + 1) * 8 * 6144;
            RN P{AOUT, YB, AOUT, modl + 5120, AIN(I_GPOSTFFN) + (size_t)l * D, nx ? AIN(I_GPREMIX) + (size_t)(l + 1) * D : nullptr, nx ? modn + 1024 : nullptr, nx ? modn : nullptr, XN, nx ? AIN(I_BF) + (size_t)(l + 1) * 8 : nullptr, nx ? (float*)(ws + WS_LF) : nullptr};
            resnorm_phase(P, (const float*)(ws + WS_WF) + (size_t)(l + 1) * D * 8, lds, tid, wave, lane, gw, ngw);
        }
        SEAM(pb + 8);
    }
}

extern "C" void kernel_launch(void* const* d_in, const int* in_sizes, int n_in, void* d_out, int out_size, void* d_ws, size_t ws_size, hipStream_t stream) {
    static int grid = 0;
    if (grid == 0) {
        if (n_in != 26 || out_size != M * D || ws_size < WS_END) { fprintf(stderr, "kernel_launch: unexpected problem: n_in %d out %d ws %zu (need %zu)\n", n_in, out_size, ws_size, (size_t)WS_END); grid = -1; return; }
        int dev = 0, cus = 0, per_cu = 0;
        hipGetDevice(&dev); hipDeviceGetAttribute(&cus, hipDeviceAttributeMultiprocessorCount, dev);
        if (hipFuncSetAttribute((const void*)mk_fwd, hipFuncAttributeMaxDynamicSharedMemorySize, LDS_BYTES) != hipSuccess) { fprintf(stderr, "kernel_launch: hipFuncSetAttribute failed\n"); grid = -1; return; }
        hipOccupancyMaxActiveBlocksPerMultiprocessor(&per_cu, (const void*)mk_fwd, NWAVES * 64, LDS_BYTES);
        (void)hipGetLastError();
        if (per_cu < 1) per_cu = 1;
        grid = cus * per_cu;
        if (grid != 256) fprintf(stderr, "kernel_launch: grid %d (cus %d x %d): this kernel is laid out for 256 workgroups\n", grid, cus, per_cu);
    }
    if (grid < 0) return;
    Args a{};
    for (int i = 0; i < 26; ++i) a.in[i] = (const float*)d_in[i];
    a.out = (float*)d_out; a.ws = (unsigned char*)d_ws;
#ifndef MK_SPLIT
    a.ph_lo = 0; a.ph_hi = 2 + 9 * NLAYER;
    void* args[] = {&a};
    hipError_t e = hipLaunchCooperativeKernel((const void*)mk_fwd, dim3(grid), dim3(NWAVES * 64), args, LDS_BYTES, stream);
    if (e != hipSuccess) fprintf(stderr, "kernel_launch: cooperative launch failed: %s (grid %d)\n", hipGetErrorString(e), grid);
#else
    for (int ph = 0; ph < 2 + 9 * NLAYER; ++ph) { a.ph_lo = ph; a.ph_hi = ph + 1; void* args[] = {&a};
        hipError_t e = hipLaunchCooperativeKernel((const void*)mk_fwd, dim3(grid), dim3(NWAVES * 64), args, LDS_BYTES, stream);
        if (e != hipSuccess) { fprintf(stderr, "kernel_launch: launch %d failed: %s\n", ph, hipGetErrorString(e)); break; } }
#endif
}
```
